# Optimizing an MI355X kernel written in HIP

```python
import jax, jax.numpy as jnp
from jax import lax
import numpy as np

D_MODEL = 2048
BATCH = 4
SEQ = 2048
DEPTH = 1
DEC_BATCH = 128
DEC_SEQ = 4
PAST_LEN = 16384
PAGE_SIZE = 128

POOL_WINDOWS = (2, 4, 8, 16)
N_POOL_GROUPS = len(POOL_WINDOWS)
D_POOL = D_MODEL // 2
POOL_GROUP = D_POOL // N_POOL_GROUPS
POOL_BUF = max(POOL_WINDOWS) - 1
N_HEADS = 4
HEAD_QK = D_MODEL // (2 * N_HEADS)
HEAD_V = D_MODEL // N_HEADS
MLSTM_CHUNK = 64
D_FF = ((8 * D_MODEL // 3 + 255) // 256) * 256
PLE_DIM = 256
EPS = 1e-6

kernel_name = 'hybrid_pool_mlstm_decoder_step'


def _rmsnorm(x, g):
    xf = x.astype(jnp.float32)
    y = xf * lax.rsqrt(jnp.mean(xf * xf, axis=-1, keepdims=True) + EPS)
    return (y * g.astype(jnp.float32)).astype(x.dtype)


def _pool_mix(u, buf, start_pos, w_grp, s_pool):
    B, S, _ = u.shape
    ext = jnp.concatenate([buf.astype(u.dtype), u], axis=1)
    extf = ext.astype(jnp.float32)
    cs = jnp.concatenate([jnp.zeros((B, 1, D_POOL), jnp.float32), jnp.cumsum(extf, axis=1)], axis=1)
    pos = start_pos + jnp.arange(S)
    hi = cs[:, POOL_BUF + 1:POOL_BUF + 1 + S]
    means = []
    for g, w in enumerate(POOL_WINDOWS):
        sl = slice(g * POOL_GROUP, (g + 1) * POOL_GROUP)
        lo = cs[:, POOL_BUF + 1 - w:POOL_BUF + 1 - w + S, sl]
        cnt = jnp.minimum(pos + 1, w).astype(jnp.float32)
        means.append((hi[:, :, sl] - lo) / cnt[None, :, None])
    z = jnp.concatenate(means, axis=-1) - u.astype(jnp.float32)
    z = z.reshape(B, S, N_POOL_GROUPS, POOL_GROUP)
    y = jnp.einsum('bsgc,gcd->bsgd', z, w_grp.astype(jnp.float32)).reshape(B, S, D_POOL)
    y = (y * s_pool.astype(jnp.float32)).astype(u.dtype)
    return y, ext[:, -POOL_BUF:].astype(buf.dtype)


def _mlstm_chunk_step(carry, xs):
    C, n, m = carry
    q, k, v, ig, lf = xs
    L = q.shape[2]
    b = jnp.cumsum(lf, axis=-1)
    causal = jnp.tril(jnp.ones((L, L), bool))
    Dm = jnp.where(causal, b[..., :, None] - b[..., None, :] + ig[..., None, :], -jnp.inf)
    a = b + m[..., None]
    m_t = jnp.maximum(a, jnp.max(Dm, axis=-1))
    inter = jnp.exp(a - m_t)
    qk = jnp.einsum('bhtd,bhjd->bhtj', q, k) * jnp.exp(Dm - m_t[..., None])
    num = inter[..., None] * jnp.einsum('bhtd,bhde->bhte', q, C) + jnp.einsum('bhtj,bhje->bhte', qk, v)
    den = inter * jnp.einsum('bhtd,bhd->bht', q, n) + jnp.sum(qk, axis=-1)
    h = num / jnp.maximum(jnp.abs(den), jnp.exp(-m_t))[..., None]
    bL = b[..., -1]
    m_new = m_t[..., -1]
    decay = jnp.exp(bL + m - m_new)
    wk = jnp.exp(bL[..., None] - b + ig - m_new[..., None])
    C_new = decay[..., None, None] * C + jnp.einsum('bhj,bhjd,bhje->bhde', wk, k, v)
    n_new = decay[..., None] * n + jnp.einsum('bhj,bhjd->bhd', wk, k)
    return (C_new, n_new, m_new), h


def _mlstm(q, k, v, ig, lf, C0, n0, m0):
    B, S, H, _ = q.shape
    L = MLSTM_CHUNK if S % MLSTM_CHUNK == 0 else S
    NC = S // L

    def to_chunks(t):
        t = t.astype(jnp.float32).reshape((B, NC, L, H) + t.shape[3:])
        return jnp.moveaxis(t, (1, 3), (0, 2))

    xs = (to_chunks(q), to_chunks(k), to_chunks(v), to_chunks(ig), to_chunks(lf))
    init = (C0.astype(jnp.float32), n0.astype(jnp.float32), m0.astype(jnp.float32))
    (C, n, m), hs = lax.scan(_mlstm_chunk_step, init, xs)
    h = jnp.moveaxis(hs, (0, 2), (1, 3)).reshape(B, S, H, HEAD_V)
    return h, C.astype(C0.dtype), n.astype(n0.dtype), m.astype(m0.dtype)


def _layer(x, p, pool_buf, start_pos, C0, n0, m0, g_pre_mix, w_in, b_i, b_f, w_pool_grp, s_pool,
           g_head, w_pa, w_pb, w_out, g_post_mix, g_pre_ffn, w_gate, w_up, w_down, g_post_ffn,
           w_ple, w_ple_gate):
    B, S, _ = x.shape
    widths = [D_POOL, N_HEADS * HEAD_QK, N_HEADS * HEAD_QK, N_HEADS * HEAD_V, N_HEADS * HEAD_V,
              N_HEADS, N_HEADS]
    split_idx = list(np.cumsum(widths))
    h = _rmsnorm(x, g_pre_mix)
    proj = h @ w_in.astype(x.dtype)
    u_pool, q, k, v, o_pre, i_pre, f_pre, gate_pre = jnp.split(proj, split_idx, axis=-1)
    a, new_buf = _pool_mix(u_pool, pool_buf, start_pos, w_pool_grp, s_pool)
    q = q.reshape(B, S, N_HEADS, HEAD_QK)
    k = k.reshape(B, S, N_HEADS, HEAD_QK) * (HEAD_QK ** -0.5)
    v = v.reshape(B, S, N_HEADS, HEAD_V)
    ig = (i_pre.astype(jnp.float32) + b_i.astype(jnp.float32))
    lf = jax.nn.log_sigmoid(f_pre.astype(jnp.float32) + b_f.astype(jnp.float32))
    hm, C, n, m = _mlstm(q, k, v, ig, lf, C0, n0, m0)
    hm = _rmsnorm(hm, g_head).astype(x.dtype)
    bm = jax.nn.sigmoid(o_pre) * hm.reshape(B, S, N_HEADS * HEAD_V)
    gates = jax.nn.sigmoid(gate_pre.astype(jnp.float32)).astype(x.dtype)
    g_a, g_b = jnp.split(gates, 2, axis=-1)
    merged = g_a * (a @ w_pa.astype(x.dtype)) + g_b * (bm @ w_pb.astype(x.dtype))
    x = x + _rmsnorm(merged @ w_out.astype(x.dtype), g_post_mix)
    h2 = _rmsnorm(x, g_pre_ffn)
    f = (jax.nn.silu(h2 @ w_gate.astype(x.dtype)) * (h2 @ w_up.astype(x.dtype))) @ w_down.astype(x.dtype)
    x = x + _rmsnorm(f, g_post_ffn)
    x = x + jax.nn.sigmoid(x @ w_ple_gate.astype(x.dtype)) * (p.astype(x.dtype) @ w_ple.astype(x.dtype))
    return x, new_buf, C, n, m


def setup_inputs(seed: int = 0) -> dict:
    key = jax.random.key(seed)
    ks = jax.random.split(key, 32)

    def nrm(k, shape, scale=1.0):
        return jax.random.normal(k, shape, jnp.float32) * scale

    H, K, V = N_HEADS, HEAD_QK, HEAD_V
    n_in = D_POOL + 2 * H * K + 2 * H * V + 2 * H + 2 * D_MODEL
    return {
        'x_prompt': nrm(ks[0], (BATCH, SEQ, D_MODEL)),
        'x_sample': nrm(ks[1], (DEC_BATCH, DEC_SEQ, D_MODEL)),
        'p_prompt': nrm(ks[2], (DEPTH, BATCH, SEQ, PLE_DIM)),
        'p_sample': nrm(ks[3], (DEPTH, DEC_BATCH, DEC_SEQ, PLE_DIM)),
        'state_pool': nrm(ks[4], (DEPTH, DEC_BATCH, POOL_BUF, D_POOL)),
        'state_C': nrm(ks[5], (DEPTH, DEC_BATCH, H, K, V), 0.5),
        'state_n': nrm(ks[6], (DEPTH, DEC_BATCH, H, K), 0.5),
        'state_m': nrm(ks[7], (DEPTH, DEC_BATCH, H)),
        'g_pre_mix': 1.0 + nrm(ks[8], (DEPTH, D_MODEL), 0.05),
        'w_in': nrm(ks[9], (DEPTH, D_MODEL, n_in), D_MODEL ** -0.5),
        'b_i': nrm(ks[10], (DEPTH, H), 0.1),
        'b_f': jnp.linspace(3.0, 6.0, H, dtype=jnp.float32)[None, :] + nrm(ks[11], (DEPTH, H), 0.1),
        'w_pool_grp': nrm(ks[12], (DEPTH, N_POOL_GROUPS, POOL_GROUP, POOL_GROUP), POOL_GROUP ** -0.5),
        's_pool': 1.0 + nrm(ks[13], (DEPTH, D_POOL), 0.1),
        'g_head': 1.0 + nrm(ks[14], (DEPTH, H, V), 0.05),
        'w_pa': nrm(ks[15], (DEPTH, D_POOL, D_MODEL), D_POOL ** -0.5),
        'w_pb': nrm(ks[16], (DEPTH, H * V, D_MODEL), (H * V) ** -0.5),
        'w_out': nrm(ks[17], (DEPTH, D_MODEL, D_MODEL), D_MODEL ** -0.5),
        'g_post_mix': 1.0 + nrm(ks[18], (DEPTH, D_MODEL), 0.05),
        'g_pre_ffn': 1.0 + nrm(ks[19], (DEPTH, D_MODEL), 0.05),
        'w_gate': nrm(ks[20], (DEPTH, D_MODEL, D_FF), D_MODEL ** -0.5),
        'w_up': nrm(ks[21], (DEPTH, D_MODEL, D_FF), D_MODEL ** -0.5),
        'w_down': nrm(ks[22], (DEPTH, D_FF, D_MODEL), D_FF ** -0.5),
        'g_post_ffn': 1.0 + nrm(ks[23], (DEPTH, D_MODEL), 0.05),
        'w_ple': nrm(ks[24], (DEPTH, PLE_DIM, D_MODEL), PLE_DIM ** -0.5),
        'w_ple_gate': nrm(ks[25], (DEPTH, D_MODEL, D_MODEL), D_MODEL ** -0.5),
    }


def reference(x_prompt, x_sample, p_prompt, p_sample, state_pool, state_C, state_n, state_m,
              g_pre_mix, w_in, b_i, b_f, w_pool_grp, s_pool, g_head, w_pa, w_pb, w_out,
              g_post_mix, g_pre_ffn, w_gate, w_up, w_down, g_post_ffn, w_ple, w_ple_gate):
    B = x_prompt.shape[0]
    yp, ys = x_prompt, x_sample
    pool_p, C_p, n_p, m_p = [], [], [], []
    pool_s, C_s, n_s, m_s = [], [], [], []
    for i in range(DEPTH):
        w = (g_pre_mix[i], w_in[i], b_i[i], b_f[i], w_pool_grp[i], s_pool[i], g_head[i], w_pa[i],
             w_pb[i], w_out[i], g_post_mix[i], g_pre_ffn[i], w_gate[i], w_up[i], w_down[i],
             g_post_ffn[i], w_ple[i], w_ple_gate[i])
        buf0 = jnp.zeros((B, POOL_BUF, D_POOL), state_pool.dtype)
        C0 = jnp.zeros((B, N_HEADS, HEAD_QK, HEAD_V), state_C.dtype)
        n0 = jnp.zeros((B, N_HEADS, HEAD_QK), state_n.dtype)
        m0 = jnp.zeros((B, N_HEADS), state_m.dtype)
        yp, bp, cp, np_, mp = _layer(yp, p_prompt[i], buf0, 0, C0, n0, m0, *w)
        ys, bs, cs, ns, ms = _layer(ys, p_sample[i], state_pool[i], PAST_LEN,
                                    state_C[i], state_n[i], state_m[i], *w)
        pool_p.append(bp); C_p.append(cp); n_p.append(np_); m_p.append(mp)
        pool_s.append(bs); C_s.append(cs); n_s.append(ns); m_s.append(ms)
    return (yp, ys, jnp.stack(pool_p), jnp.stack(C_p), jnp.stack(n_p), jnp.stack(m_p),
            jnp.stack(pool_s), jnp.stack(C_s), jnp.stack(n_s), jnp.stack(m_s))
```

```cpp
#include <hip/hip_runtime.h>
#include <hip/hip_cooperative_groups.h>
#include <cstdio>
namespace cg = cooperative_groups;

#define LAS __attribute__((address_space(3)))
typedef unsigned short bf16_t;
typedef short bf16x8 __attribute__((ext_vector_type(8)));
typedef float f32x4 __attribute__((ext_vector_type(4)));
typedef unsigned u32x4 __attribute__((ext_vector_type(4)));
typedef unsigned u32x2 __attribute__((ext_vector_type(2)));

constexpr int T = 8704, TP = 8192, TS = 512, DM = 2048, NIN = 11272, NP = 11264, DP = 1024, HQK = 1024, HV = 2048, DFF = 5632, PLE = 256;
constexpr float EPS = 1e-6f, LOG2E = 1.4426950408889634f;
constexpr size_t OUT_YS = (size_t)TP * DM, OUT_POOLP = OUT_YS + (size_t)TS * DM, OUT_CP = OUT_POOLP + 4 * 15 * 1024,
                 OUT_NP = OUT_CP + (size_t)16 * 256 * 512, OUT_MP = OUT_NP + 16 * 256, OUT_POOLS = OUT_MP + 16,
                 OUT_CS = OUT_POOLS + (size_t)128 * 15 * 1024, OUT_NS = OUT_CS + (size_t)512 * 256 * 512, OUT_MS = OUT_NS + 512 * 256;
constexpr size_t O_WIN = 0;
constexpr size_t O_WGU = O_WIN + (size_t)NP * DM * 2;
constexpr size_t O_WDN = O_WGU + (size_t)NP * DM * 2;
constexpr size_t O_WPA = O_WDN + (size_t)DM * DFF * 2;
constexpr size_t O_WPB = O_WPA + (size_t)DM * DP * 2;
constexpr size_t O_WOUT = O_WPB + (size_t)DM * DM * 2;
constexpr size_t O_WPG = O_WOUT + (size_t)DM * DM * 2;
constexpr size_t O_WPLE = O_WPG + (size_t)DM * DM * 2;
constexpr size_t O_WGRP = O_WPLE + (size_t)DM * PLE * 2;
constexpr size_t O_H1 = O_WGRP + (size_t)DP * 256 * 2;
constexpr size_t O_SO = O_H1 + (size_t)T * DM * 2;
constexpr size_t O_GA = O_SO + (size_t)T * DM * 2;
constexpr size_t O_GB = O_GA + (size_t)T * DM * 2;
constexpr size_t O_NUM = O_GB + (size_t)T * DM * 2;
constexpr size_t O_BM = O_NUM + (size_t)T * DM * 2;
constexpr size_t O_T1 = O_BM + (size_t)T * DM * 2;
constexpr size_t O_PE = O_T1 + (size_t)T * DM * 2;
constexpr size_t O_V = O_PE + (size_t)T * DM * 2;
constexpr size_t O_U = O_V + (size_t)TS * HV * 2;
constexpr size_t O_Q = O_U + (size_t)T * 1024 * 2;
constexpr size_t O_K = O_Q + (size_t)T * 1024 * 2;
constexpr size_t O_Z = O_K + (size_t)T * 1024 * 2;
constexpr size_t O_A = O_Z + (size_t)T * 1024 * 2;
constexpr size_t O_VT = O_A + (size_t)T * 1024 * 2;
constexpr size_t O_KWT = O_VT + (size_t)HV * TP * 2;
constexpr size_t O_PBF = O_KWT + (size_t)HQK * TP * 2;
constexpr size_t O_S = O_PBF + (size_t)T * PLE * 2;
constexpr size_t O_X1 = O_S + (size_t)TP * 8192 * 2;
constexpr size_t O_IG = O_X1 + (size_t)T * DM * 4;
constexpr size_t O_LF = O_IG + (size_t)T * 4 * 4;
constexpr size_t O_SU = O_LF + (size_t)T * 4 * 4;
constexpr size_t O_SW = O_SU + 16 * 2048 * 4;
constexpr size_t O_SEM = O_SW + 16 * 2048 * 4;
constexpr size_t O_SWKF = O_SEM + 16 * 2048 * 4;
constexpr size_t O_DENP = O_SWKF + 16 * 2048 * 4;
constexpr size_t O_SSQ = O_DENP + (size_t)16 * 2048 * 32 * 4;
constexpr size_t O_FLAG = O_SSQ + (size_t)T * 32 * 4;
constexpr size_t O_BAR = O_FLAG + 1024 * 64 * 4;
constexpr size_t O_PART = O_BAR + 16384;
constexpr size_t O_END = O_PART + (size_t)256 * 32 * 512 * 16;
static_assert((size_t)T * DFF * 2 <= (size_t)TP * 8192 * 2, "act alias");

constexpr int LDS_BYTES = 147456;
#ifndef REP_PHASE
#define REP_PHASE -1
#define REP_N 1
#define REPI 0
#endif
#ifndef P2M
#define P2M 15
#endif
#ifndef PHM
#define PHM 0xFFF
#endif

struct Params {
    const float *x_prompt, *x_sample, *p_prompt, *p_sample, *state_pool, *state_C, *state_n, *state_m, *g_pre_mix, *w_in, *b_i, *b_f,
        *w_pool_grp, *s_pool, *g_head, *w_pa, *w_pb, *w_out, *g_post_mix, *g_pre_ffn, *w_gate, *w_up, *w_down, *g_post_ffn, *w_ple, *w_ple_gate;
    float* out;
    unsigned char* ws;
};

__device__ __forceinline__ unsigned pk2(float lo, float hi) { unsigned r; asm("v_cvt_pk_bf16_f32 %0, %1, %2" : "=v"(r) : "v"(lo), "v"(hi)); return r; }
__device__ __forceinline__ float bflo(unsigned w) { return __uint_as_float(w << 16); }
__device__ __forceinline__ float bfhi(unsigned w) { return __uint_as_float(w & 0xffff0000u); }
__device__ __forceinline__ float bf1(bf16_t v) { return __uint_as_float(((unsigned)v) << 16); }
__device__ __forceinline__ float wave_sum(float v) {
#pragma unroll
    for (int o = 1; o < 64; o <<= 1) v += __shfl_xor(v, o);
    return v;
}
__device__ __forceinline__ float fsigmoid(float x) { return __builtin_amdgcn_rcpf(1.0f + __builtin_amdgcn_exp2f(-x * LOG2E)); }
__device__ __forceinline__ u32x4 pack8(const f32x4 v0, const f32x4 v1) { u32x4 w; w.x = pk2(v0[0], v0[1]); w.y = pk2(v0[2], v0[3]); w.z = pk2(v1[0], v1[1]); w.w = pk2(v1[2], v1[3]); return w; }
__device__ __forceinline__ f32x4 unlo(const u32x4 w) { return (f32x4){bflo(w.x), bfhi(w.x), bflo(w.y), bfhi(w.y)}; }
__device__ __forceinline__ f32x4 unhi(const u32x4 w) { return (f32x4){bflo(w.z), bfhi(w.z), bflo(w.w), bfhi(w.w)}; }
__device__ __forceinline__ f32x4 sig4(f32x4 v) { return (f32x4){fsigmoid(v[0]), fsigmoid(v[1]), fsigmoid(v[2]), fsigmoid(v[3])}; }
#define LDS_WAIT() asm volatile("s_waitcnt lgkmcnt(0)" ::: "memory")

constexpr int BK = 64, HALF = 128, HTB = HALF * BK * 2;
__device__ __forceinline__ int lds_byte(int r, int c) { const int st = (r >> 4) * 2 + (c >> 5), rr = r & 15, cc = c & 31, ob = rr * 64 + cc * 2; return st * 1024 + (ob ^ (((ob >> 9) & 1) << 5)); }
__device__ __forceinline__ void stage_rc(int b, int& R, int& C) { const int st = b / 1024, sb = b % 1024, swz = sb ^ (((sb >> 9) & 1) << 5); R = (st >> 1) * 16 + swz / 64; C = (st & 1) * 32 + (swz % 64) / 2; }
__device__ __forceinline__ int perm32(int rho) { const int n = rho >> 4, i = rho & 15; return 8 * (i >> 2) + 4 * n + (i & 3); }

struct Unit { const char* A; const char* B; int nt, pm, pn, z, mode, slot; };

__device__ __forceinline__ int xcd_remap(int L, int nwg) { const int q = nwg / 8, r = nwg % 8, xcd = L % 8, off = L / 8; return (xcd < r ? xcd * (q + 1) : r * (q + 1) + (xcd - r) * q) + off; }
__device__ __forceinline__ void grouped(int w, int nM, int nN, int& pm, int& pn) { const int nig = 8 * nN, gid = w / nig, fm = gid * 8, gsz = (nM - fm) < 8 ? (nM - fm) : 8; pm = fm + ((w % nig) % gsz); pn = (w % nig) / gsz; }

template <class Sched, class Epi>
__device__ __forceinline__ void gemm_phase(LAS unsigned char* lds, const int lda, const int ldb, const Sched& S, const Epi& E, float* part = nullptr, unsigned* flags = nullptr, unsigned target = 0u) {
    const int tid = threadIdx.x, wid = __builtin_amdgcn_readfirstlane(tid >> 6), lane = tid & 63, wr = wid >> 2, wc = wid & 3, fr = lane & 15, fq = lane >> 4;
    unsigned voffA[2], voffB[2];
#pragma unroll
    for (int i = 0; i < 2; ++i) { int R, C; stage_rc(tid * 16 + i * 8192, R, C); const int Rb = (R & ~31) + perm32(R & 31);
        voffA[i] = (unsigned)(R * lda + C) * 2u; voffB[i] = (unsigned)(Rb * ldb + C) * 2u; }
    const size_t kstep = (size_t)(BK * 2);
    const size_t hstepA = (size_t)HALF * lda * 2, hstepB = (size_t)HALF * ldb * 2;
    const unsigned ldsw = (unsigned)wid * 1024u;
    const int aoff = lds_byte(wr * 64 + fr, fq * 8), boff = lds_byte(wc * 32 + fr, fq * 8);
#define PG8_SA(b, h) (((b) * 2 + (h)) * HTB)
#define PG8_SB(b, h) ((4 + (b) * 2 + (h)) * HTB)
#define PG8_STAGE(bufoff, gbase, voff) do { _Pragma("unroll") for (int _i = 0; _i < 2; ++_i) \
        __builtin_amdgcn_global_load_lds((const unsigned*)((const char*)(gbase) + (voff)[_i]), (LAS unsigned*)(lds + (bufoff) + ldsw + _i * 8192), 16, 0, 0); } while (0)
#define PG8_LDA(dst, b, h) do { _Pragma("unroll") for (int m = 0; m < 4; ++m) _Pragma("unroll") for (int k = 0; k < 2; ++k) dst[m][k] = *(const LAS bf16x8*)(lds + PG8_SA(b, h) + aoff + m * 2048 + k * 1024); } while (0)
#define PG8_LDB(dst, b, h) do { _Pragma("unroll") for (int n = 0; n < 2; ++n) _Pragma("unroll") for (int k = 0; k < 2; ++k) dst[n][k] = *(const LAS bf16x8*)(lds + PG8_SB(b, h) + boff + n * 2048 + k * 1024); } while (0)
#define PG8_MMA(ai, bj, At, Bt) do { __builtin_amdgcn_s_setprio(1); _Pragma("unroll") for (int m = 0; m < 4; ++m) _Pragma("unroll") for (int n = 0; n < 2; ++n) _Pragma("unroll") for (int k = 0; k < 2; ++k) \
        acc[ai][bj][m][n] = __builtin_amdgcn_mfma_f32_16x16x32_bf16(Bt[n][k], At[m][k], acc[ai][bj][m][n], 0, 0, 0); __builtin_amdgcn_s_setprio(0); } while (0)
#define PG8_WAIT_V(n) asm volatile("s_waitcnt vmcnt(" #n ")" ::: "memory")
#define PG8_WAIT_L(n) asm volatile("s_waitcnt lgkmcnt(" #n ")" ::: "memory")
#define PG8_BAR __builtin_amdgcn_s_barrier()
#define PG8_SCHED __builtin_amdgcn_sched_barrier(0)
    Unit cur, nxt; int ui = 0;
    if (!S.next(0, cur)) return;
    f32x4 acc[2][2][4][2];
#pragma unroll
    for (int a = 0; a < 2; ++a)
#pragma unroll
        for (int b = 0; b < 2; ++b)
#pragma unroll
            for (int m = 0; m < 4; ++m)
#pragma unroll
                for (int n = 0; n < 2; ++n) acc[a][b][m][n] = (f32x4){0.f, 0.f, 0.f, 0.f};
    bf16x8 At[4][2], B0[2][2], B1[2][2];
    const char* cA = cur.A; const char* cB = cur.B;
    PG8_STAGE(PG8_SB(0, 0), cB, voffB); PG8_STAGE(PG8_SA(0, 0), cA, voffA); PG8_STAGE(PG8_SB(0, 1), cB + hstepB, voffB); PG8_STAGE(PG8_SA(0, 1), cA + hstepA, voffA);
    if (wr == 1) PG8_BAR;
    PG8_WAIT_V(4); PG8_BAR;
    PG8_STAGE(PG8_SB(1, 0), cB + kstep, voffB); PG8_STAGE(PG8_SA(1, 0), cA + kstep, voffA); PG8_STAGE(PG8_SB(1, 1), cB + hstepB + kstep, voffB);
    PG8_WAIT_V(6); PG8_BAR;
    for (;;) {
        const bool has_next = S.next(ui + 1, nxt);
        const char* nA = has_next ? nxt.A : cA; const char* nB = has_next ? nxt.B : cB;
        int nt = cur.nt; asm volatile("" : "+s"(nt));
        for (int t = 0; t < nt; t += 2) {
            const bool last = (t == nt - 2);
            const char* a1 = cA + (size_t)(t + 1) * kstep;
            const char* a2 = last ? nA : cA + (size_t)(t + 2) * kstep; const char* b2 = last ? nB : cB + (size_t)(t + 2) * kstep;
            asm volatile("" : "+s"(a1), "+s"(a2), "+s"(b2));
            const char* a3 = a2 + kstep; const char* b3 = b2 + kstep;
            PG8_LDB(B0, 0, 0); PG8_SCHED; PG8_LDA(At, 0, 0); PG8_STAGE(PG8_SA(1, 1), a1 + hstepA, voffA);
            PG8_WAIT_L(8); PG8_BAR; PG8_WAIT_L(0); PG8_MMA(0, 0, At, B0); PG8_BAR; PG8_SCHED;
            PG8_LDB(B1, 0, 1); PG8_STAGE(PG8_SB(0, 0), b2, voffB);
            PG8_BAR; PG8_WAIT_L(0); PG8_MMA(0, 1, At, B1); PG8_BAR;
            PG8_LDA(At, 0, 1); PG8_STAGE(PG8_SA(0, 0), a2, voffA);
            PG8_BAR; PG8_WAIT_L(0); PG8_MMA(1, 0, At, B0); PG8_BAR; PG8_SCHED;
            PG8_STAGE(PG8_SB(0, 1), b2 + hstepB, voffB);
            PG8_WAIT_V(6); PG8_BAR; PG8_MMA(1, 1, At, B1); PG8_BAR;
            PG8_LDB(B0, 1, 0); PG8_SCHED; PG8_LDA(At, 1, 0); PG8_STAGE(PG8_SA(0, 1), a2 + hstepA, voffA);
            PG8_WAIT_L(8); PG8_BAR; PG8_WAIT_L(0); PG8_MMA(0, 0, At, B0); PG8_BAR; PG8_SCHED;
            PG8_LDB(B1, 1, 1); PG8_STAGE(PG8_SB(1, 0), b3, voffB);
            PG8_BAR; PG8_WAIT_L(0); PG8_MMA(0, 1, At, B1); PG8_BAR;
            PG8_LDA(At, 1, 1); PG8_STAGE(PG8_SA(1, 0), a3, voffA);
            PG8_BAR; PG8_WAIT_L(0); PG8_MMA(1, 0, At, B0); PG8_BAR; PG8_SCHED;
            PG8_STAGE(PG8_SB(1, 1), b3 + hstepB, voffB);
            PG8_WAIT_V(6); PG8_BAR; PG8_MMA(1, 1, At, B1); PG8_BAR;
        }
        if constexpr (Sched::SK) {
            if (cur.mode == 2) {
                while (__hip_atomic_load(flags + cur.slot * 16, __ATOMIC_RELAXED, __HIP_MEMORY_SCOPE_AGENT) < target) __builtin_amdgcn_s_sleep(2);
                const __amdgpu_buffer_rsrc_t rl_ = __builtin_amdgcn_make_buffer_rsrc((void*)((char*)part + (size_t)cur.slot * 131072), (short)0, 131072, 0x00020000);
#pragma unroll
                for (int a = 0; a < 2; ++a) {
                    u32x4 tmp[8];
#pragma unroll
                    for (int j = 0; j < 8; ++j) tmp[j] = __builtin_amdgcn_raw_buffer_load_b128(rl_, tid * 16, (a * 8 + j) * 8192, 16);
                    asm volatile("s_waitcnt vmcnt(0)" ::: "memory");
#pragma unroll
                    for (int j = 0; j < 8; ++j) { acc[a][j >> 2][j & 3][0] += unlo(tmp[j]); acc[a][j >> 2][j & 3][1] += unhi(tmp[j]); }
                    __builtin_amdgcn_sched_barrier(0);
                }
            }
            __builtin_amdgcn_sched_barrier(0);
            if (cur.mode == 1) {
                const __amdgpu_buffer_rsrc_t rs = __builtin_amdgcn_make_buffer_rsrc((void*)((char*)part + (size_t)cur.slot * 131072), (short)0, 131072, 0x00020000);
#pragma unroll
                for (int a = 0; a < 2; ++a)
#pragma unroll
                    for (int b = 0; b < 2; ++b)
#pragma unroll
                        for (int m = 0; m < 4; ++m)
                            __builtin_amdgcn_raw_buffer_store_b128(pack8(acc[a][b][m][0], acc[a][b][m][1]), rs, tid * 16, ((a * 2 + b) * 4 + m) * 8192, 16);
                asm volatile("s_waitcnt vmcnt(0)" ::: "memory");
                if (lane == 0) __hip_atomic_fetch_add(flags + cur.slot * 16, 1u, __ATOMIC_RELAXED, __HIP_MEMORY_SCOPE_AGENT);
            } else {
                E(acc, cur, wr, wc, fr, fq);
            }
        } else {
            E(acc, cur, wr, wc, fr, fq);
        }
        if (!has_next) break;
#pragma unroll
        for (int a = 0; a < 2; ++a)
#pragma unroll
            for (int b = 0; b < 2; ++b)
#pragma unroll
                for (int m = 0; m < 4; ++m)
#pragma unroll
                    for (int n = 0; n < 2; ++n) acc[a][b][m][n] = (f32x4){0.f, 0.f, 0.f, 0.f};
        cur = nxt; cA = nA; cB = nB; ++ui;
    }
    PG8_WAIT_V(0);
    if (wr == 0) PG8_BAR;
    PG8_BAR;
#undef PG8_SA
#undef PG8_SB
#undef PG8_STAGE
#undef PG8_LDA
#undef PG8_LDB
#undef PG8_MMA
#undef PG8_WAIT_V
#undef PG8_WAIT_L
#undef PG8_BAR
#undef PG8_SCHED
}

typedef f32x4 Acc[2][2][4][2];

struct SchedU {
    static constexpr bool SK = false;
    int G, c, nM, nN, nt; const char* A; const char* B; size_t tA, tB;
    __device__ __forceinline__ void init(int G_, int c_, const void* A_, int lda, const void* B_, int ldb, int nM_, int nN_, int K) {
        G = G_; c = c_; nM = nM_; nN = nN_; nt = K / BK; A = (const char*)A_; B = (const char*)B_; tA = (size_t)256 * lda * 2; tB = (size_t)256 * ldb * 2; }
    __device__ __forceinline__ bool next(int i, Unit& u) const { u.mode = 0; u.slot = 0;
        const int nwg = nM * nN; const long L = (long)i * G + c; if (L >= nwg) return false;
        const int w = xcd_remap((int)L, nwg); int pm, pn; grouped(w, nM, nN, pm, pn);
        u.A = A + (size_t)pm * tA; u.B = B + (size_t)pn * tB; u.nt = nt; u.pm = pm; u.pn = pn; u.z = 0; return true; }
};
struct SchedK {
    static constexpr bool SK = true;
    int nM, nN, n; const char* A; const char* B; size_t tA, tB; int s0, s1, cpos;
    __device__ __forceinline__ void init(int G, int bid, const void* A_, int lda, const void* B_, int ldb, int nM_, int nN_, int K) {
        nM = nM_; nN = nN_; n = K / (2 * BK); A = (const char*)A_; B = (const char*)B_; tA = (size_t)256 * lda * 2; tB = (size_t)256 * ldb * 2;
        cpos = (G % 8 == 0) ? (bid % 8) * (G / 8) + bid / 8 : bid;
        const long TT = (long)nM * nN * n; s0 = (int)((long)cpos * TT / G); s1 = (int)((long)(cpos + 1) * TT / G); }
    __device__ __forceinline__ void piece(Unit& u, int ui, int t0, int nt_, int mode, int slot) const {
        int pm, pn; grouped(ui, nM, nN, pm, pn);
        u.A = A + (size_t)pm * tA + (size_t)t0 * (4 * BK); u.B = B + (size_t)pn * tB + (size_t)t0 * (4 * BK); u.nt = 2 * nt_; u.pm = pm; u.pn = pn; u.z = 0; u.mode = mode; u.slot = slot; }
    __device__ __forceinline__ bool next(int i, Unit& u) const {
        const int u0 = s0 / n, o0 = s0 % n, u1 = s1 / n, e = s1 % n, fstart = (o0 > 0) ? u0 + 1 : u0, nfull = u1 - fstart;
        int k = i;
        if (e > 0) { if (k == 0) { piece(u, u1, 0, e, 1, cpos); return true; } --k; }
        if (k < nfull) { piece(u, fstart + k, 0, n, 0, 0); return true; }
        k -= nfull;
        if (o0 > 0 && k == 0) { piece(u, u0, o0, n - o0, 2, cpos - 1); return true; }
        return false; }
};
struct SchedP1 {
    static constexpr bool SK = false;
    int G, c; const char* h1; const char* WinT;
    __device__ __forceinline__ bool next(int i, Unit& u) const { u.mode = 0; u.slot = 0;
        const int nwg = 1496; const long L = (long)i * G + c; if (L >= nwg) return false;
        int w = xcd_remap((int)L, nwg); int pm, pn; const size_t ts = (size_t)256 * 2048 * 2;
        u.nt = 32; u.z = 0;
        { const int x = w / 187, o = w % 187;
          if (o < 48) w = 48 * x + o; else if (o < 144) w = 384 + 96 * x + (o - 48); else if (o < 176) w = 1240 + 32 * x + (o - 144); else w = 1152 + 11 * x + (o - 176); }
        if (w < 384) { grouped(w, 32, 12, pm, pn); }
        else if (w < 1152) { grouped(w - 384, 32, 24, pm, pn); pn += 20; }
        else if (w < 1240) { grouped(w - 1152, 2, 44, pm, pn); pm += 32; }
        else { grouped(w - 1240, 8, 32, pm, pn); u.z = 1; u.A = WinT + (size_t)(12 + pm) * ts; u.B = h1 + (size_t)pn * ts; u.pm = pm; u.pn = pn; return true; }
        u.A = h1 + (size_t)pm * ts; u.B = WinT + (size_t)pn * ts; u.pm = pm; u.pn = pn; return true; }
};
struct SchedQK {
    static constexpr bool SK = false;
    int G, c; const char* q; const char* k;
    __device__ __forceinline__ bool next(int i, Unit& u) const { u.mode = 0; u.slot = 0;
        const long L = (long)i * G + c; if (L >= 576) return false;
        const int bh = (int)L / 36, tri = (int)L % 36; int pm = 0, rem = tri;
        while (rem > pm) { rem -= pm + 1; ++pm; }
        const int pn = rem, b = bh >> 2, h = bh & 3;
        u.A = q + ((size_t)(b * 2048 + pm * 256) * 1024 + h * 256) * 2; u.B = k + ((size_t)(b * 2048 + pn * 256) * 1024 + h * 256) * 2;
        u.nt = 4; u.pm = pm; u.pn = pn; u.z = bh; return true; }
};
struct SchedSV {
    static constexpr bool SK = false;
    int G, c; const char* S; const char* vT; const char* kwT;
    __device__ __forceinline__ bool next(int i, Unit& u) const { u.mode = 0; u.slot = 0;
        if ((long)i * G >= 288) return false;
        const int o = (i & 1) ? (i * G + (G - 1 - c)) : (i * G + c); if (o >= 288) return false;
        if (o < 32) { const int bh = o >> 1, pn = o & 1, b = bh >> 2, h = bh & 3;
            u.A = kwT + ((size_t)(h * 256) * TP + b * 2048) * 2; u.B = vT + ((size_t)(h * 512 + pn * 256) * TP + b * 2048) * 2; u.nt = 32; u.pm = 0; u.pn = pn; u.z = 16 + bh; return true; }
        const int o2 = o - 32, pm = 7 - (o2 >> 5), rem = o2 & 31, bh = rem >> 1, pn = rem & 1, b = bh >> 2, h = bh & 3;
        u.A = S + ((size_t)(b * 2048 + pm * 256) * 8192 + h * 2048) * 2; u.B = vT + ((size_t)(h * 512 + pn * 256) * TP + b * 2048) * 2; u.nt = 4 * (pm + 1); u.pm = pm; u.pn = pn; u.z = bh; return true; }
};
struct SchedPool {
    static constexpr bool SK = false;
    int G, c; const char* zb; const char* Wg;
    __device__ __forceinline__ bool next(int i, Unit& u) const { u.mode = 0; u.slot = 0;
        const long L = (long)i * G + c; if (L >= 136) return false;
        const int g = (int)L / 34, pm = (int)L % 34;
        u.A = zb + ((size_t)pm * 256 * 1024 + g * 256) * 2; u.B = Wg + (size_t)g * 65536 * 2; u.nt = 4; u.pm = pm; u.pn = 0; u.z = g; return true; }
};

struct SchedPe {
    static constexpr bool SK = false;
    int G, c; const char* p; const char* W;
    __device__ __forceinline__ bool next(int i, Unit& u) const { u.mode = 0; u.slot = 0;
        const int skip = (272 - G > 0 && 272 - G < G) ? 272 - G : 0; if (c < skip) return false;
        const long L = (long)i * (G - skip) + (c - skip); if (L >= 272) return false;
        const int pm = (int)L % 34, pn = (int)L / 34;
        u.A = p + (size_t)pm * 256 * PLE * 2; u.B = W + (size_t)pn * 256 * PLE * 2; u.nt = 4; u.pm = pm; u.pn = pn; u.z = 0; return true; }
};

#define EPI_LAUNDER int lr_ = 64 * wr + fr, lc_ = 32 * wc + 8 * fq; asm volatile("" : "+v"(lr_), "+v"(lc_));
#define EPI_ROWS_BEGIN _Pragma("unroll") for (int ai = 0; ai < 2; ++ai) _Pragma("unroll") for (int m = 0; m < 4; ++m) { const int rl = 128 * ai + 16 * m + lr_;
#define EPI_ROWS_END }

struct EpiP1 {
    bf16_t *u, *q, *k, *v, *so, *ga, *gb, *vT;
    __device__ __forceinline__ void operator()(const Acc& acc, const Unit& un, int wr, int wc, int fr, int fq) const { EPI_LAUNDER
        bf16_t* dst; int ldc; float scale = 1.f; bool sg = false; long row0 = (long)un.pm * 256;
        if (un.z == 1) { dst = vT + un.pn * 256; ldc = TP; }
        else { const int tn = un.pn;
            if (tn < 4) { dst = u + tn * 256; ldc = 1024; }
            else if (tn < 8) { dst = q + (tn - 4) * 256; ldc = 1024; }
            else if (tn < 12) { dst = k + (tn - 8) * 256; ldc = 1024; scale = 0.0625f; }
            else if (tn < 20) { dst = v + (tn - 12) * 256; ldc = 2048; row0 -= TP; }
            else if (tn < 28) { dst = so + (tn - 20) * 256; ldc = 2048; sg = true; }
            else if (tn < 36) { dst = ga + (tn - 28) * 256; ldc = 2048; sg = true; }
            else { dst = gb + (tn - 36) * 256; ldc = 2048; sg = true; } }
        const int cl0 = lc_;
        EPI_ROWS_BEGIN
            bf16_t* rp = dst + (size_t)(row0 + rl) * ldc + cl0;
#pragma unroll
            for (int bj = 0; bj < 2; ++bj) { f32x4 v0 = acc[ai][bj][m][0], v1 = acc[ai][bj][m][1];
                if (sg) { v0 = sig4(v0); v1 = sig4(v1); } else { v0 = v0 * scale; v1 = v1 * scale; }
                *(u32x4*)(rp + bj * HALF) = pack8(v0, v1); }
        EPI_ROWS_END
    }
};
struct EpiBf {
    bf16_t* dst; int ldc;
    __device__ __forceinline__ void operator()(const Acc& acc, const Unit& un, int wr, int wc, int fr, int fq) const { EPI_LAUNDER
        bf16_t* d0 = dst + (size_t)un.pm * 256 * ldc + un.pn * 256 + lc_;
        EPI_ROWS_BEGIN
            bf16_t* rp = d0 + (size_t)rl * ldc;
#pragma unroll
            for (int bj = 0; bj < 2; ++bj) *(u32x4*)(rp + bj * HALF) = pack8(acc[ai][bj][m][0], acc[ai][bj][m][1]);
        EPI_ROWS_END
    }
};
struct EpiS {
    bf16_t* S; const float* su; const float* sw; float* denp;
    __device__ __forceinline__ void operator()(const Acc& acc, const Unit& un, int wr, int wc, int fr, int fq) const { EPI_LAUNDER
        const int bh = un.z, b = bh >> 2, h = bh & 3; const bool diag = (un.pm == un.pn);
        const int cl0 = lc_;
        f32x4 ww[2][2];
#pragma unroll
        for (int bj = 0; bj < 2; ++bj)
#pragma unroll
            for (int n = 0; n < 2; ++n) ww[bj][n] = *(const f32x4*)(sw + bh * 2048 + un.pn * 256 + bj * HALF + cl0 + 4 * n);
        float uu8[2][4];
#pragma unroll
        for (int ai = 0; ai < 2; ++ai)
#pragma unroll
            for (int m = 0; m < 4; ++m) uu8[ai][m] = su[bh * 2048 + un.pm * 256 + 128 * ai + 16 * m + lr_];
        EPI_ROWS_BEGIN
            const int srow = un.pm * 256 + rl; const float uu = uu8[ai][m]; float rs = 0.f; const int lim = diag ? rl : 0x7fffffff;
            bf16_t* rp = S + (size_t)(b * 2048 + srow) * 8192 + h * 2048 + un.pn * 256 + cl0;
#pragma unroll
            for (int bj = 0; bj < 2; ++bj) { f32x4 o[2];
#pragma unroll
                for (int n = 0; n < 2; ++n)
#pragma unroll
                    for (int e = 0; e < 4; ++e) { float val = acc[ai][bj][m][n][e] * __builtin_amdgcn_exp2f(uu + ww[bj][n][e]);
                        if (bj * HALF + cl0 + 4 * n + e > lim) val = 0.f;
                        o[n][e] = val; rs += val; }
                *(u32x4*)(rp + bj * HALF) = pack8(o[0], o[1]); }
            rs += __shfl_xor(rs, 16); rs += __shfl_xor(rs, 32);
            if (fq == 0) denp[(size_t)(bh * 2048 + srow) * 32 + un.pn * 4 + wc] = rs;
        EPI_ROWS_END
    }
};
struct EpiSV {
    bf16_t* num; float* Cp;
    __device__ __forceinline__ void operator()(const Acc& acc, const Unit& un, int wr, int wc, int fr, int fq) const { EPI_LAUNDER
        const int cl0 = lc_;
        if (un.z < 16) { const int bh = un.z, b = bh >> 2, h = bh & 3;
            bf16_t* d0 = num + (size_t)(b * 2048 + un.pm * 256) * 2048 + h * 512 + un.pn * 256 + cl0;
            EPI_ROWS_BEGIN
                bf16_t* rp = d0 + (size_t)rl * 2048;
#pragma unroll
                for (int bj = 0; bj < 2; ++bj) *(u32x4*)(rp + bj * HALF) = pack8(acc[ai][bj][m][0], acc[ai][bj][m][1]);
            EPI_ROWS_END
        } else { const int bh = un.z - 16;
            float* d0 = Cp + (size_t)bh * 256 * 512 + un.pn * 256 + cl0;
            EPI_ROWS_BEGIN
                float* rp = d0 + (size_t)rl * 512;
#pragma unroll
                for (int bj = 0; bj < 2; ++bj) { *(f32x4*)(rp + bj * HALF) = acc[ai][bj][m][0]; *(f32x4*)(rp + bj * HALF + 4) = acc[ai][bj][m][1]; }
            EPI_ROWS_END
        }
    }
};
struct EpiPool {
    bf16_t* a; const float* sp;
    __device__ __forceinline__ void operator()(const Acc& acc, const Unit& un, int wr, int wc, int fr, int fq) const { EPI_LAUNDER
        const int c0 = un.z * 256 + lc_;
        f32x4 s[2][2];
#pragma unroll
        for (int bj = 0; bj < 2; ++bj)
#pragma unroll
            for (int n = 0; n < 2; ++n) s[bj][n] = *(const f32x4*)(sp + c0 + bj * HALF + 4 * n);
        EPI_ROWS_BEGIN
            bf16_t* rp = a + (size_t)(un.pm * 256 + rl) * 1024 + c0;
#pragma unroll
            for (int bj = 0; bj < 2; ++bj) *(u32x4*)(rp + bj * HALF) = pack8(acc[ai][bj][m][0] * s[bj][0], acc[ai][bj][m][1] * s[bj][1]);
        EPI_ROWS_END
    }
};
struct EpiPA {
    bf16_t* T1; const bf16_t* ga;
    __device__ __forceinline__ void operator()(const Acc& acc, const Unit& un, int wr, int wc, int fr, int fq) const { EPI_LAUNDER
        const size_t o0 = (size_t)un.pm * 256 * 2048 + un.pn * 256 + lc_;
        u32x4 gg[2][4][2];
#pragma unroll
        for (int ai = 0; ai < 2; ++ai)
#pragma unroll
            for (int m = 0; m < 4; ++m)
#pragma unroll
                for (int bj = 0; bj < 2; ++bj) gg[ai][m][bj] = *(const u32x4*)(ga + o0 + (size_t)(128 * ai + 16 * m + lr_) * 2048 + bj * HALF);
        EPI_ROWS_BEGIN
            const size_t ro = o0 + (size_t)rl * 2048;
#pragma unroll
            for (int bj = 0; bj < 2; ++bj) { const u32x4 g = gg[ai][m][bj];
                *(u32x4*)(T1 + ro + bj * HALF) = pack8(acc[ai][bj][m][0] * unlo(g), acc[ai][bj][m][1] * unhi(g)); }
        EPI_ROWS_END
    }
};
struct EpiPB {
    bf16_t* mg; const bf16_t* T1; const bf16_t* gb;
    __device__ __forceinline__ void operator()(const Acc& acc, const Unit& un, int wr, int wc, int fr, int fq) const { EPI_LAUNDER
        const size_t o0 = (size_t)un.pm * 256 * 2048 + un.pn * 256 + lc_;
#pragma unroll
        for (int ai = 0; ai < 2; ++ai) {
            u32x4 g4[4][2], t4[4][2];
#pragma unroll
            for (int m = 0; m < 4; ++m)
#pragma unroll
                for (int bj = 0; bj < 2; ++bj) { const size_t ro = o0 + (size_t)(128 * ai + 16 * m + lr_) * 2048 + bj * HALF; g4[m][bj] = *(const u32x4*)(gb + ro); t4[m][bj] = *(const u32x4*)(T1 + ro); }
            __builtin_amdgcn_sched_barrier(0);
#pragma unroll
            for (int m = 0; m < 4; ++m) { const size_t ro = o0 + (size_t)(128 * ai + 16 * m + lr_) * 2048;
#pragma unroll
                for (int bj = 0; bj < 2; ++bj) *(u32x4*)(mg + ro + bj * HALF) = pack8(unlo(t4[m][bj]) + acc[ai][bj][m][0] * unlo(g4[m][bj]), unhi(t4[m][bj]) + acc[ai][bj][m][1] * unhi(g4[m][bj]));
                __builtin_amdgcn_sched_barrier(0); }
        }
    }
};
struct EpiSq {
    bf16_t* dst; float* ssq;
    __device__ __forceinline__ void operator()(const Acc& acc, const Unit& un, int wr, int wc, int fr, int fq) const { EPI_LAUNDER
        const size_t o0 = (size_t)un.pm * 256 * 2048 + un.pn * 256 + lc_;
        EPI_ROWS_BEGIN
            const size_t ro = o0 + (size_t)rl * 2048; float rs = 0.f;
#pragma unroll
            for (int bj = 0; bj < 2; ++bj) { const f32x4 v0 = acc[ai][bj][m][0], v1 = acc[ai][bj][m][1];
                rs += v0[0] * v0[0] + v0[1] * v0[1] + v0[2] * v0[2] + v0[3] * v0[3] + v1[0] * v1[0] + v1[1] * v1[1] + v1[2] * v1[2] + v1[3] * v1[3];
                *(u32x4*)(dst + ro + bj * HALF) = pack8(v0, v1); }
            rs += __shfl_xor(rs, 16); rs += __shfl_xor(rs, 32);
            if (fq == 0) ssq[(size_t)(un.pm * 256 + rl) * 32 + un.pn * 4 + wc] = rs;
        EPI_ROWS_END
    }
};
struct EpiSwi {
    bf16_t* act; const float* rs;
    __device__ __forceinline__ void operator()(const Acc& acc, const Unit& un, int wr, int wc, int fr, int fq) const { EPI_LAUNDER
        bf16_t* d0 = act + (size_t)un.pm * 256 * DFF + un.pn * 128 + lc_;
        float r8[2][4];
#pragma unroll
        for (int ai = 0; ai < 2; ++ai)
#pragma unroll
            for (int m = 0; m < 4; ++m) r8[ai][m] = rs[un.pm * 256 + 128 * ai + 16 * m + lr_];
        EPI_ROWS_BEGIN
            const float r = r8[ai][m];
            const f32x4 g0 = acc[ai][0][m][0] * r, g1 = acc[ai][0][m][1] * r, u0 = acc[ai][1][m][0] * r, u1 = acc[ai][1][m][1] * r;
            *(u32x4*)(d0 + (size_t)rl * DFF) = pack8(g0 * sig4(g0) * u0, g1 * sig4(g1) * u1);
        EPI_ROWS_END
    }
};
struct EpiPle {
    float* y; const bf16_t* x2; const bf16_t* pe;
    __device__ __forceinline__ void operator()(const Acc& acc, const Unit& un, int wr, int wc, int fr, int fq) const { EPI_LAUNDER
        const size_t o0 = (size_t)un.pm * 256 * 2048 + un.pn * 256 + lc_;
#pragma unroll
        for (int ai = 0; ai < 2; ++ai) {
            u32x4 p4[4][2], x4[4][2];
#pragma unroll
            for (int m = 0; m < 4; ++m)
#pragma unroll
                for (int bj = 0; bj < 2; ++bj) { const size_t ro = o0 + (size_t)(128 * ai + 16 * m + lr_) * 2048 + bj * HALF; p4[m][bj] = *(const u32x4*)(pe + ro); x4[m][bj] = *(const u32x4*)(x2 + ro); }
            __builtin_amdgcn_sched_barrier(0);
#pragma unroll
            for (int m = 0; m < 4; ++m) { const size_t ro = o0 + (size_t)(128 * ai + 16 * m + lr_) * 2048;
#pragma unroll
                for (int bj = 0; bj < 2; ++bj) {
                    *(f32x4*)(y + ro + bj * HALF) = unlo(x4[m][bj]) + sig4(acc[ai][bj][m][0]) * unlo(p4[m][bj]);
                    *(f32x4*)(y + ro + bj * HALF + 4) = unhi(x4[m][bj]) + sig4(acc[ai][bj][m][1]) * unhi(p4[m][bj]); }
                __builtin_amdgcn_sched_barrier(0); }
        }
    }
};

__device__ __forceinline__ void transpose_item(const float* src, int ldw, bf16_t* dst, int ldd, LAS float* scr, int lane, const float* ks = nullptr) {
    f32x4 v[8];
#pragma unroll
    for (int i = 0; i < 8; ++i) v[i] = *(const f32x4*)(src + (size_t)(i * 8 + (lane >> 3)) * ldw + (lane & 7) * 4);
    if (ks) {
        float kv[8];
#pragma unroll
        for (int i = 0; i < 8; ++i) kv[i] = ks[i * 8 + (lane >> 3)];
#pragma unroll
        for (int i = 0; i < 8; ++i) v[i] = v[i] * kv[i]; }
#pragma unroll
    for (int i = 0; i < 8; ++i) { LAS float* s = scr + (i * 8 + (lane >> 3)) * 33 + (lane & 7) * 4; s[0] = v[i][0]; s[1] = v[i][1]; s[2] = v[i][2]; s[3] = v[i][3]; }
    LDS_WAIT();
    const int c = lane & 7;
#pragma unroll
    for (int j = 0; j < 4; ++j) { const int n = (lane >> 3) + 8 * j; const LAS float* s = scr + (8 * c) * 33 + n;
        u32x4 o; o.x = pk2(s[0 * 33], s[1 * 33]); o.y = pk2(s[2 * 33], s[3 * 33]); o.z = pk2(s[4 * 33], s[5 * 33]); o.w = pk2(s[6 * 33], s[7 * 33]);
        *(u32x4*)(dst + (size_t)n * ldd + 8 * c) = o; }
    LDS_WAIT();
}

__device__ __forceinline__ void weight_item(const Params& P, int it, LAS float* scr, int lane) {
    unsigned char* ws = P.ws;
    int r = it;
    if (r < 7168) { const int kb = r / 224, nb = r % 224; transpose_item(P.w_in + (size_t)kb * 64 * NIN + nb * 32, NIN, (bf16_t*)(ws + O_WIN) + (size_t)(nb * 32) * DM + kb * 64, DM, scr, lane); return; } r -= 7168;
    if (r < 4096) { const int kb = r / 128, nb = r % 128; transpose_item(P.w_in + (size_t)kb * 64 * NIN + 7176 + nb * 32, NIN, (bf16_t*)(ws + O_WIN) + (size_t)(7168 + nb * 32) * DM + kb * 64, DM, scr, lane); return; } r -= 4096;
    if (r < 5632) { const int kb = r / 176, nb = r % 176, n0 = nb * 32; transpose_item(P.w_gate + (size_t)kb * 64 * DFF + n0, DFF, (bf16_t*)(ws + O_WGU) + (size_t)((n0 >> 7) * 256 + (n0 & 127)) * DM + kb * 64, DM, scr, lane, P.g_pre_ffn + kb * 64); return; } r -= 5632;
    if (r < 5632) { const int kb = r / 176, nb = r % 176, n0 = nb * 32; transpose_item(P.w_up + (size_t)kb * 64 * DFF + n0, DFF, (bf16_t*)(ws + O_WGU) + (size_t)((n0 >> 7) * 256 + 128 + (n0 & 127)) * DM + kb * 64, DM, scr, lane, P.g_pre_ffn + kb * 64); return; } r -= 5632;
    if (r < 5632) { const int kb = r / 64, nb = r % 64; transpose_item(P.w_down + (size_t)kb * 64 * DM + nb * 32, DM, (bf16_t*)(ws + O_WDN) + (size_t)(nb * 32) * DFF + kb * 64, DFF, scr, lane); return; } r -= 5632;
    if (r < 1024) { const int kb = r / 64, nb = r % 64; transpose_item(P.w_pa + (size_t)kb * 64 * DM + nb * 32, DM, (bf16_t*)(ws + O_WPA) + (size_t)(nb * 32) * DP + kb * 64, DP, scr, lane); return; } r -= 1024;
    if (r < 2048) { const int kb = r / 64, nb = r % 64; transpose_item(P.w_pb + (size_t)kb * 64 * DM + nb * 32, DM, (bf16_t*)(ws + O_WPB) + (size_t)(nb * 32) * DM + kb * 64, DM, scr, lane); return; } r -= 2048;
    if (r < 2048) { const int kb = r / 64, nb = r % 64; transpose_item(P.w_out + (size_t)kb * 64 * DM + nb * 32, DM, (bf16_t*)(ws + O_WOUT) + (size_t)(nb * 32) * DM + kb * 64, DM, scr, lane); return; } r -= 2048;
    if (r < 2048) { const int kb = r / 64, nb = r % 64; transpose_item(P.w_ple_gate + (size_t)kb * 64 * DM + nb * 32, DM, (bf16_t*)(ws + O_WPG) + (size_t)(nb * 32) * DM + kb * 64, DM, scr, lane); return; } r -= 2048;
    if (r < 256) { const int kb = r / 64, nb = r % 64; transpose_item(P.w_ple + (size_t)kb * 64 * DM + nb * 32, DM, (bf16_t*)(ws + O_WPLE) + (size_t)(nb * 32) * PLE + kb * 64, PLE, scr, lane); return; } r -= 256;
    { const int g = r / 32, rr = r % 32, kb = rr / 8, nb = rr % 8;
      transpose_item(P.w_pool_grp + (size_t)g * 65536 + (size_t)kb * 64 * 256 + nb * 32, 256, (bf16_t*)(ws + O_WGRP) + (size_t)g * 65536 + (size_t)(nb * 32) * 256 + kb * 64, 256, scr, lane); }
}
constexpr int N_WITEMS = 7168 + 4096 + 5632 * 3 + 1024 + 2048 * 3 + 256 + 128;
constexpr int W_DN0 = 7168 + 4096 + 5632 * 2, W_PB0 = 7168 + 4096 + 5632 * 3 + 1024, W_LATE0 = W_PB0 + 2048, W_LATE1 = W_LATE0 + 2048 * 2;

template <int W>
__device__ __forceinline__ void pool_z_item(const Params& P, const bf16_t* ub, bf16_t* zb, int t, int ch0) {
    f32x4 sa = {0.f, 0.f, 0.f, 0.f}, sb = {0.f, 0.f, 0.f, 0.f}; float cnt; u32x4 cur;
    if (t < TP) { const int s = t & 2047, n = (s + 1 < W) ? s + 1 : W; cnt = (float)n;
        u32x4 r[W];
#pragma unroll
        for (int i = 0; i < W; ++i) r[i] = (i < n) ? *(const u32x4*)(ub + (size_t)(t - i) * 1024 + ch0) : (u32x4){0u, 0u, 0u, 0u};
        cur = r[0];
#pragma unroll
        for (int i = 0; i < W; ++i) { sa += unlo(r[i]); sb += unhi(r[i]); } }
    else { const int bs = (t - TP) >> 2, s = (t - TP) & 3; cnt = (float)W;
        cur = *(const u32x4*)(ub + (size_t)t * 1024 + ch0);
#pragma unroll
        for (int i = 0; i < W; ++i) { const int e = 15 + s - i;
            if (e >= 15) { const u32x4 r = *(const u32x4*)(ub + (size_t)(TP + bs * 4 + (e - 15)) * 1024 + ch0); sa += unlo(r); sb += unhi(r); }
            else { const float* sp = P.state_pool + ((size_t)bs * 15 + e) * 1024 + ch0; sa += *(const f32x4*)sp; sb += *(const f32x4*)(sp + 4); } } }
    const float ic = 1.f / cnt;
    *(u32x4*)(zb + (size_t)t * 1024 + ch0) = pack8(sa * ic - unlo(cur), sb * ic - unhi(cur));
}

__device__ __forceinline__ void sample_item(const Params& P, int item, LAS float* L) {
    const int tid = threadIdx.x, lane = tid & 63, wid = tid >> 6;
    const int b = item >> 2, h = item & 3, t0 = TP + b * 4;
    unsigned char* ws = P.ws;
    const bf16_t* qb = (const bf16_t*)(ws + O_Q); const bf16_t* kb = (const bf16_t*)(ws + O_K); const bf16_t* vb = (const bf16_t*)(ws + O_V);
    const float* igp = (const float*)(ws + O_IG); const float* lfp = (const float*)(ws + O_LF);
    LAS float* qs = L;
    LAS float* ks = L + 1024;
    LAS float* vs = L + 2048;
    LAS float* n0s = L + 4096;
    LAS float* red = L + 4352;
    LAS float* nred = L + 4608;
    for (int idx = tid; idx < 1024; idx += 512) { const int t = idx >> 8, d = idx & 255;
        qs[d * 4 + t] = bf1(qb[(size_t)(t0 + t) * 1024 + h * 256 + d]); ks[d * 4 + t] = bf1(kb[(size_t)(t0 + t) * 1024 + h * 256 + d]); }
    for (int idx = tid; idx < 2048; idx += 512) { const int t = idx >> 9, e = idx & 511; vs[idx] = bf1(vb[(size_t)(b * 4 + t) * 2048 + h * 512 + e]); }
    if (tid < 256) n0s[tid] = P.state_n[(size_t)(b * 4 + h) * 256 + tid];
    float bc[4], igv[4], mt[4], inter[4], Dt[4][4];
    const float m0 = P.state_m[b * 4 + h];
    { float cs = 0.f;
#pragma unroll
      for (int t = 0; t < 4; ++t) { cs += lfp[(t0 + t) * 4 + h]; bc[t] = cs; igv[t] = igp[(t0 + t) * 4 + h]; } }
#pragma unroll
    for (int t = 0; t < 4; ++t) { const float a = bc[t] + m0; float mm = a;
#pragma unroll
        for (int j = 0; j < 4; ++j) if (j <= t) mm = fmaxf(mm, bc[t] - bc[j] + igv[j]);
        mt[t] = mm; inter[t] = __expf(a - mm);
#pragma unroll
        for (int j = 0; j < 4; ++j) Dt[t][j] = (j <= t) ? __expf(bc[t] - bc[j] + igv[j] - mm) : 0.f; }
    const float m_new = mt[3], bL = bc[3], decay = __expf(bL + m0 - m_new);
    float wk[4];
#pragma unroll
    for (int j = 0; j < 4; ++j) wk[j] = __expf(bL - bc[j] + igv[j] - m_new);
    __syncthreads();
    for (int dt = wid; dt < 20; dt += 8) { float s = 0.f;
        if (dt < 16) { const int t = dt >> 2, j = dt & 3;
#pragma unroll
            for (int i = 0; i < 4; ++i) { const int d = lane + 64 * i; s += qs[d * 4 + t] * ks[d * 4 + j]; } }
        else { const int t = dt - 16;
#pragma unroll
            for (int i = 0; i < 4; ++i) { const int d = lane + 64 * i; s += qs[d * 4 + t] * n0s[d]; } }
        s = wave_sum(s); if (lane == 0) red[dt] = s; }
    __syncthreads();
    LAS float* sc = L + 4384;
    if (tid == 0) {
#pragma unroll
        for (int t = 0; t < 4; ++t) { float ds = inter[t] * red[16 + t];
#pragma unroll
            for (int j = 0; j < 4; ++j) { const float sv = red[t * 4 + j] * Dt[t][j]; sc[8 + t * 4 + j] = sv; ds += sv; }
            sc[t] = inter[t]; sc[4 + t] = fmaxf(fabsf(ds), __expf(-mt[t])); sc[24 + t] = wk[t]; }
    }
    __syncthreads();
    for (int idx = tid; idx < 1024; idx += 512) ks[idx] *= sc[24 + (idx & 3)];
    __syncthreads();
    const int cgp = tid & 127, dg = tid >> 7;
    f32x4 vv[4], nq[4];
#pragma unroll
    for (int j = 0; j < 4; ++j) { vv[j] = *(const LAS f32x4*)(vs + j * 512 + cgp * 4); nq[j] = (f32x4){0.f, 0.f, 0.f, 0.f}; }
    const f32x4* Cin = (const f32x4*)(P.state_C + (size_t)(b * 4 + h) * 256 * 512) + cgp;
    f32x4* Cout = (f32x4*)(P.out + OUT_CS + (size_t)(b * 4 + h) * 256 * 512) + cgp;
    for (int d0 = dg * 64; d0 < dg * 64 + 64; d0 += 16) {
        f32x4 cc[16];
#pragma unroll
        for (int i = 0; i < 16; ++i) cc[i] = __builtin_nontemporal_load(Cin + (size_t)(d0 + i) * 128);
#pragma unroll
        for (int i = 0; i < 16; ++i) { const f32x4 qd = *(const LAS f32x4*)(qs + (d0 + i) * 4), kd = *(const LAS f32x4*)(ks + (d0 + i) * 4);
            nq[0] += cc[i] * qd[0]; nq[1] += cc[i] * qd[1]; nq[2] += cc[i] * qd[2]; nq[3] += cc[i] * qd[3];
            f32x4 cn = cc[i] * decay + vv[0] * kd[0] + vv[1] * kd[1] + vv[2] * kd[2] + vv[3] * kd[3];
            __builtin_nontemporal_store(cn, Cout + (size_t)(d0 + i) * 128); }
    }
#pragma unroll
    for (int t = 0; t < 4; ++t) *(LAS f32x4*)(nred + (dg * 4 + t) * 512 + cgp * 4) = nq[t];
    __syncthreads();
    bf16_t* numb = (bf16_t*)(ws + O_NUM);
#pragma unroll
    for (int i = 0; i < 4; ++i) { const int idx = tid + 512 * i, t = idx >> 9, e = idx & 511;
        const float nqs = nred[(0 * 4 + t) * 512 + e] + nred[(1 * 4 + t) * 512 + e] + nred[(2 * 4 + t) * 512 + e] + nred[(3 * 4 + t) * 512 + e];
        const float it_ = sc[t], dd = sc[4 + t], s0 = sc[8 + t * 4], s1 = sc[9 + t * 4], s2 = sc[10 + t * 4], s3 = sc[11 + t * 4];
        const float val = it_ * nqs + s0 * vs[e] + s1 * vs[512 + e] + s2 * vs[1024 + e] + s3 * vs[1536 + e];
        const float hv = val / dd;
        numb[(size_t)(t0 + t) * 2048 + h * 512 + e] = (bf16_t)(pk2(hv, 0.f) & 0xffffu); }
    if (tid < 256) { const f32x4 kd = *(const LAS f32x4*)(ks + tid * 4);
        P.out[OUT_NS + (size_t)(b * 4 + h) * 256 + tid] = decay * n0s[tid] + kd[0] + kd[1] + kd[2] + kd[3]; }
    if (tid == 0) P.out[OUT_MS + b * 4 + h] = m_new;
    __syncthreads();
}


#define XB_TMO      128
#define XB_XCNT(j)  (256  + 64 * (j))
#define XB_XSUB(j)  (1280 + 64 * (j))
#define XB_XGEN(j)  (2304 + 64 * (j))
#define XB_TOP      3328
#define XB_TOPGEN   3392
#define XCD_BAR_WORDS 3456
#define XB_SPIN_CAP (1u << 22)
__device__ __forceinline__ unsigned xb_ld(unsigned* p)              { return __hip_atomic_load(p, __ATOMIC_RELAXED, __HIP_MEMORY_SCOPE_AGENT); }
__device__ __forceinline__ unsigned xb_add(unsigned* p, unsigned v) { return __hip_atomic_fetch_add(p, v, __ATOMIC_RELAXED, __HIP_MEMORY_SCOPE_AGENT); }
__device__ __forceinline__ unsigned xb_xcc_id() { return (unsigned)__builtin_amdgcn_s_getreg((3 << 11) | 20) & 0xFu; }
#define XB_SPIN(cond, bar) do { unsigned _sp = 0; while (cond) { __builtin_amdgcn_s_sleep(1); \
    if ((++_sp & 255u) == 0u) { if (xb_ld(&(bar)[XB_TMO])) break; if (_sp > XB_SPIN_CAP) { atomicAdd(&(bar)[XB_TMO], 1u); break; } } } } while (0)
struct XcdBarrier { unsigned* bar; unsigned x; volatile LAS unsigned* st; };
__device__ __forceinline__ XcdBarrier xcd_barrier_post(unsigned* bar, volatile LAS unsigned* st) {
    XcdBarrier b; b.bar = bar; b.x = xb_xcc_id(); b.st = st;
    if (threadIdx.x == 0) (void)xb_add(&bar[XB_XCNT(b.x)], 1u);
    return b;
}
__device__ __forceinline__ void xcd_barrier_complete(unsigned* bar, unsigned x, unsigned& nloc, unsigned& nx) {
    const unsigned G = gridDim.x * gridDim.y * gridDim.z;
    unsigned sum, cnt, mine, sp = 0u;
    for (;;) {
        sum = 0u; cnt = 0u; mine = 0u;
#pragma unroll
        for (unsigned j = 0; j < 16; ++j) { const unsigned c = xb_ld(&bar[XB_XCNT(j)]); sum += c; cnt += (c > 0u) ? 1u : 0u; mine = (j == x) ? c : mine; }
        if (sum == G) break;
        __builtin_amdgcn_s_sleep(1);
        if ((++sp & 255u) == 0u) { if (xb_ld(&bar[XB_TMO])) break; if (sp > XB_SPIN_CAP) { atomicAdd(&bar[XB_TMO], 1u); break; } }
    }
    nloc = mine > 0u ? mine : 1u; nx = cnt > 0u ? cnt : 1u;
}
__device__ __forceinline__ void xcd_barrier(const XcdBarrier& b) {
    asm volatile("s_waitcnt vmcnt(0)" ::: "memory");
    __syncthreads();
    if (threadIdx.x == 0) {
        unsigned* bar = b.bar;
        __builtin_amdgcn_s_waitcnt(0);
        unsigned nloc = b.st[0], nx = b.st[1];
        if (nloc == 0u) { xcd_barrier_complete(bar, b.x, nloc, nx); b.st[0] = nloc; b.st[1] = nx; }
        const unsigned old = xb_add(&bar[XB_XSUB(b.x)], 1u);
        const unsigned gen = old / nloc;
        if (old + 1u == (gen + 1u) * nloc) {
            __builtin_amdgcn_fence(__ATOMIC_RELEASE, "agent");
            asm volatile("s_waitcnt vmcnt(0)" ::: "memory");
            const unsigned og = xb_add(&bar[XB_TOP], 1u);
            const unsigned tg = og / nx;
            if (og + 1u == (tg + 1u) * nx) xb_add(&bar[XB_TOPGEN], 1u);
            else XB_SPIN(xb_ld(&bar[XB_TOPGEN]) == tg, bar);
            __builtin_amdgcn_fence(__ATOMIC_ACQUIRE, "agent");
            xb_add(&bar[XB_XGEN(b.x)], 1u);
            asm volatile("s_waitcnt vmcnt(0)" ::: "memory");
        } else {
            XB_SPIN(xb_ld(&bar[XB_XGEN(b.x)]) == gen, bar);
            __builtin_amdgcn_fence(__ATOMIC_ACQUIRE, "agent");
            asm volatile("s_waitcnt vmcnt(0)" ::: "memory");
        }
    }
    __syncthreads();
}

#define WinT ((bf16_t*)(ws + O_WIN))
#define WguT ((bf16_t*)(ws + O_WGU))
#define WdnT ((bf16_t*)(ws + O_WDN))
#define WpaT ((bf16_t*)(ws + O_WPA))
#define WpbT ((bf16_t*)(ws + O_WPB))
#define WoutT ((bf16_t*)(ws + O_WOUT))
#define WpgT ((bf16_t*)(ws + O_WPG))
#define WpleT ((bf16_t*)(ws + O_WPLE))
#define WgrpT ((bf16_t*)(ws + O_WGRP))
#define h1 ((bf16_t*)(ws + O_H1))
#define merged h1
#define so ((bf16_t*)(ws + O_SO))
#define x2b so
#define ga ((bf16_t*)(ws + O_GA))
#define gb ((bf16_t*)(ws + O_GB))
#define numb ((bf16_t*)(ws + O_NUM))
#define tout numb
#define bm ((bf16_t*)(ws + O_BM))
#define h2 bm
#define T1 ((bf16_t*)(ws + O_T1))
#define fout T1
#define pe ((bf16_t*)(ws + O_PE))
#define vs_ ((bf16_t*)(ws + O_V))
#define ub ((bf16_t*)(ws + O_U))
#define qb ((bf16_t*)(ws + O_Q))
#define kb ((bf16_t*)(ws + O_K))
#define zb ((bf16_t*)(ws + O_Z))
#define ab ((bf16_t*)(ws + O_A))
#define vT ((bf16_t*)(ws + O_VT))
#define kwT ((bf16_t*)(ws + O_KWT))
#define pbf ((bf16_t*)(ws + O_PBF))
#define Sall ((bf16_t*)(ws + O_S))
#define act Sall
#define x1b ((bf16_t*)(ws + O_X1))
#define rs2b ((float*)(ws + O_SU))
#define igp ((float*)(ws + O_IG))
#define lfp ((float*)(ws + O_LF))
#define su ((float*)(ws + O_SU))
#define sw ((float*)(ws + O_SW))
#define sem ((float*)(ws + O_SEM))
#define swkf ((float*)(ws + O_SWKF))
#define denp ((float*)(ws + O_DENP))
#define ssq ((float*)(ws + O_SSQ))
#define part ((float*)(ws + O_PART))
#define flags ((unsigned*)(ws + O_FLAG))
#define barw ((unsigned*)(ws + O_BAR))
__global__ void __launch_bounds__(512, 2) mega(Params P) {
    extern __shared__ __attribute__((aligned(16))) unsigned char lds_raw[];
    LAS unsigned char* lds = (LAS unsigned char*)lds_raw;
    cg::grid_group grid = cg::this_grid();
    const int tid = threadIdx.x, lane = tid & 63, wid = __builtin_amdgcn_readfirstlane(tid >> 6), G = gridDim.x, bid = blockIdx.x;
    const int gw = bid * 8 + wid, NGW = G * 8;
    unsigned char* ws = P.ws;

    if constexpr ((PHM >> 0) & 1)
    {
        LAS float* WgT = (LAS float*)lds;
        if (bid == 0) { for (int i = tid; i < 5 * 256 + 1; i += 512) flags[i * 16] = 0u; for (int i = tid; i < XCD_BAR_WORDS; i += 512) barw[i] = 0u; }
        if (tid < 4) ((volatile LAS unsigned*)(lds + LDS_BYTES - 16))[tid] = 0u;
        for (int k = tid; k < 2048; k += 512) { const f32x4 a = *(const f32x4*)(P.w_in + (size_t)k * NIN + 7168), b2 = *(const f32x4*)(P.w_in + (size_t)k * NIN + 7172);
            WgT[0 * 2048 + k] = a[0]; WgT[1 * 2048 + k] = a[1]; WgT[2 * 2048 + k] = a[2]; WgT[3 * 2048 + k] = a[3];
            WgT[4 * 2048 + k] = b2[0]; WgT[5 * 2048 + k] = b2[1]; WgT[6 * 2048 + k] = b2[2]; WgT[7 * 2048 + k] = b2[3]; }
        __syncthreads();
        for (int t = gw; t < T; t += NGW) {
            const float* xr = (t < TP) ? P.x_prompt + (size_t)t * DM : P.x_sample + (size_t)(t - TP) * DM;
            f32x4 v[8]; float ss = 0.f;
#pragma unroll
            for (int j = 0; j < 8; ++j) { v[j] = ((const f32x4*)xr)[lane + 64 * j]; ss += v[j][0] * v[j][0] + v[j][1] * v[j][1] + v[j][2] * v[j][2] + v[j][3] * v[j][3]; }
            ss = wave_sum(ss); const float rstd = rsqrtf(ss * (1.f / DM) + EPS);
            u32x2* hr = (u32x2*)(h1 + (size_t)t * DM);
#pragma unroll
            for (int j = 0; j < 8; ++j) { const f32x4 g = ((const f32x4*)P.g_pre_mix)[lane + 64 * j]; v[j] = v[j] * rstd * g;
                u32x2 o; o.x = pk2(v[j][0], v[j][1]); o.y = pk2(v[j][2], v[j][3]); hr[lane + 64 * j] = o; }
            float gacc[8];
#pragma unroll
            for (int c = 0; c < 8; ++c) { float s = 0.f;
#pragma unroll
                for (int j = 0; j < 8; ++j) { const f32x4 w = *(const LAS f32x4*)(WgT + c * 2048 + 256 * j + 4 * lane); s += v[j][0] * w[0] + v[j][1] * w[1] + v[j][2] * w[2] + v[j][3] * w[3]; }
                gacc[c] = wave_sum(s); }
            if (lane == 0) {
#pragma unroll
                for (int hh = 0; hh < 4; ++hh) { igp[t * 4 + hh] = gacc[hh] + P.b_i[hh]; const float f = gacc[4 + hh] + P.b_f[hh];
                    lfp[t * 4 + hh] = fminf(f, 0.f) - log1pf(__expf(-fabsf(f))); } }
        }
        __syncthreads();
        LAS float* scr = (LAS float*)(lds + 65536) + wid * (64 * 33);
        for (int it = gw; it < 11264 + 1024 + (N_WITEMS - W_LATE1); it += NGW) {
            const int r = it < 11264 ? it : (it < 11264 + 1024 ? it - 11264 + (W_PB0 - 1024) : it - (11264 + 1024) + W_LATE1);
            weight_item(P, r, scr, lane); }
        for (int idx = bid * 512 + tid; idx < T * 32; idx += G * 512) { const int t = idx >> 5, c8 = (idx & 31) * 8;
            const float* pr = (t < TP) ? P.p_prompt + (size_t)t * PLE : P.p_sample + (size_t)(t - TP) * PLE;
            const f32x4 a = *(const f32x4*)(pr + c8), b2 = *(const f32x4*)(pr + c8 + 4);
            *(u32x4*)(pbf + (size_t)t * PLE + c8) = pack8(a, b2); }
    }
    grid.sync();
    const XcdBarrier xb = xcd_barrier_post(barw, (volatile LAS unsigned*)(lds + LDS_BYTES - 16));

    if constexpr ((PHM >> 1) & 1)
    {
        SchedP1 S1{G, bid, (const char*)h1, (const char*)WinT};
        EpiP1 E1{ub, qb, kb, vs_, so, ga, gb, vT};
        gemm_phase(lds, 2048, 2048, S1, E1);
        {
            const int rem = 1496 % G, nsl = rem ? G - rem : G, sl = rem ? bid - rem : bid;
            if (sl >= 0) { LAS float* scr = (LAS float*)lds + wid * (64 * 33);
                for (int it = W_LATE0 + sl * 8 + wid; it < W_LATE1; it += nsl * 8) weight_item(P, it, scr, lane); }
        }
        const int bh = bid - (G - 16);
        if (bh >= 0 && bh < 16 && wid == 0) {
            const int b = bh >> 2, h = bh & 3; float Bc = 0.f, Mc = 0.f;
            float lv[32], wv[32];
#pragma unroll
            for (int c = 0; c < 32; ++c) { const int t = b * 2048 + c * 64 + lane; lv[c] = lfp[t * 4 + h]; wv[c] = igp[t * 4 + h]; }
#pragma unroll
            for (int c = 0; c < 32; ++c) { const int s = c * 64 + lane;
                float cs = lv[c];
#pragma unroll
                for (int o = 1; o < 64; o <<= 1) { const float y = __shfl_up(cs, o); if (lane >= o) cs += y; }
                const float Bt = Bc + cs, w = wv[c] - Bt; float mx = w;
#pragma unroll
                for (int o = 1; o < 64; o <<= 1) { const float y = __shfl_up(mx, o); if (lane >= o) mx = fmaxf(mx, y); }
                mx = fmaxf(mx, Mc); wv[c] = w;
                su[bh * 2048 + s] = -mx * LOG2E; sw[bh * 2048 + s] = w * LOG2E; sem[bh * 2048 + s] = __expf(-(Bt + mx));
                Bc = __shfl(Bt, 63); Mc = __shfl(mx, 63); }
#pragma unroll
            for (int c = 0; c < 32; ++c) { const int s = c * 64 + lane; swkf[bh * 2048 + s] = __builtin_amdgcn_exp2f((wv[c] - Mc) * LOG2E); }
            if (lane == 0) P.out[OUT_MP + bh] = Bc + Mc;
        }
    }
    xcd_barrier(xb);

    if constexpr ((PHM >> 2) & 1)
    {
        SchedQK S1{G, bid, (const char*)qb, (const char*)kb};
        EpiS E1{Sall, su, sw, denp};
        if constexpr (P2M & 1) gemm_phase(lds, 1024, 1024, S1, E1);
        if constexpr (P2M & 2)
        for (int idx = bid * 512 + tid; idx < T * 128; idx += G * 512) {
            const int t = idx >> 7, ch0 = (idx & 127) * 8, g = ch0 >> 8;
            if (g == 0) pool_z_item<2>(P, ub, zb, t, ch0); else if (g == 1) pool_z_item<4>(P, ub, zb, t, ch0);
            else if (g == 2) pool_z_item<8>(P, ub, zb, t, ch0); else pool_z_item<16>(P, ub, zb, t, ch0);
        }
        for (int idx = bid * 512 + tid; idx < 4 * 15 * 128; idx += G * 512) { const int c8 = (idx & 127) * 8, r = (idx >> 7) % 15, b = idx / (15 * 128);
            const u32x4 v = *(const u32x4*)(ub + (size_t)(b * 2048 + 2033 + r) * 1024 + c8); float* o = P.out + OUT_POOLP + ((size_t)b * 15 + r) * 1024 + c8;
            *(f32x4*)o = unlo(v); *(f32x4*)(o + 4) = unhi(v); }
        for (int idx = bid * 512 + tid; idx < 128 * 15 * 128; idx += G * 512) { const int c8 = (idx & 127) * 8, r = (idx >> 7) % 15, b = idx / (15 * 128);
            float* o = P.out + OUT_POOLS + ((size_t)b * 15 + r) * 1024 + c8;
            if (r < 11) { const float* sp = P.state_pool + ((size_t)b * 15 + r + 4) * 1024 + c8; *(f32x4*)o = *(const f32x4*)sp; *(f32x4*)(o + 4) = *(const f32x4*)(sp + 4); }
            else { const u32x4 v = *(const u32x4*)(ub + (size_t)(TP + b * 4 + (r - 11)) * 1024 + c8); *(f32x4*)o = unlo(v); *(f32x4*)(o + 4) = unhi(v); } }
        if constexpr (P2M & 4) {
            LAS float* scr = (LAS float*)lds + wid * (64 * 33);
            for (int it = gw; it < 128 * 32; it += NGW) { const int tb = it >> 5, db = it & 31, tok0 = tb * 64, d0 = db * 32, b = tok0 >> 11, h = d0 >> 8, bh = b * 4 + h;
#pragma unroll
                for (int i = 0; i < 4; ++i) { const int r = i * 16 + (lane >> 2); const u32x4 raw = *(const u32x4*)(kb + (size_t)(tok0 + r) * 1024 + d0 + (lane & 3) * 8);
                    const float wv = swkf[bh * 2048 + (tok0 & 2047) + r]; LAS float* s = scr + r * 33 + (lane & 3) * 8; const f32x4 a = unlo(raw) * wv, b2 = unhi(raw) * wv;
                    s[0] = a[0]; s[1] = a[1]; s[2] = a[2]; s[3] = a[3]; s[4] = b2[0]; s[5] = b2[1]; s[6] = b2[2]; s[7] = b2[3]; }
                LDS_WAIT();
                const int c = lane & 7;
#pragma unroll
                for (int j = 0; j < 4; ++j) { const int d = (lane >> 3) + 8 * j; const LAS float* s = scr + (8 * c) * 33 + d;
                    u32x4 o; o.x = pk2(s[0 * 33], s[1 * 33]); o.y = pk2(s[2 * 33], s[3 * 33]); o.z = pk2(s[4 * 33], s[5 * 33]); o.w = pk2(s[6 * 33], s[7 * 33]);
                    *(u32x4*)(kwT + (size_t)(d0 + d) * TP + tok0 + 8 * c) = o; }
                LDS_WAIT();
            }
            {
                const int rem = 576 % G, nsl = rem ? G - rem : G, sl = rem ? bid - rem : bid;
                if (sl >= 0) for (int it = 16896 + sl * 8 + wid; it < 16896 + 5632; it += nsl * 8) weight_item(P, it, scr, lane);
            }
        }
        __syncthreads();
    }
    xcd_barrier(xb);

    if constexpr ((PHM >> 3) & 1)
    {
        SchedSV S1{G, bid, (const char*)Sall, (const char*)vT, (const char*)kwT};
        EpiSV E1{numb, P.out + OUT_CP};
        gemm_phase(lds, 8192, 8192, S1, E1);
        SchedPool S2{G, bid, (const char*)zb, (const char*)WgrpT};
        EpiPool E2{ab, P.s_pool};
        gemm_phase(lds, 1024, 256, S2, E2);
        __syncthreads();
        {
            volatile LAS int* qslot = (volatile LAS int*)(lds + LDS_BYTES - 32);
            for (;;) {
                if (tid == 0) *qslot = (int)__hip_atomic_fetch_add(flags + 5 * 4096, 1u, __ATOMIC_RELAXED, __HIP_MEMORY_SCOPE_AGENT);
                __syncthreads();
                const int item = *qslot;
                __syncthreads();
                if (item >= 512) break;
                sample_item(P, item, (LAS float*)lds);
            }
        }
        for (int r = gw; r < 16 * 256; r += NGW) { const int bh = r >> 8, d = r & 255, b = bh >> 2, h = bh & 3; float s = 0.f;
            const bf16_t* kr = kwT + (size_t)(h * 256 + d) * TP + b * 2048;
#pragma unroll
            for (int j = 0; j < 4; ++j) { const u32x4 w = *(const u32x4*)(kr + (lane + 64 * j) * 8); const f32x4 a = unlo(w), b2 = unhi(w); s += a[0] + a[1] + a[2] + a[3] + b2[0] + b2[1] + b2[2] + b2[3]; }
            s = wave_sum(s); if (lane == 0) P.out[OUT_NP + r] = s; }
    }
    xcd_barrier(xb);

    if constexpr ((PHM >> 4) & 1)
    {
        for (int t = gw; t < T; t += NGW) {
            u32x4 raw[4], sr[4]; float dsum[4], emv[4];
#pragma unroll
            for (int h = 0; h < 4; ++h) { raw[h] = *(const u32x4*)(numb + (size_t)t * 2048 + h * 512 + lane * 8); sr[h] = *(const u32x4*)(so + (size_t)t * 2048 + h * 512 + lane * 8); dsum[h] = 0.f; emv[h] = 1.f; }
            if (t < TP) { const int b = t >> 11, s = t & 2047, cnt = 4 * ((s >> 8) + 1);
#pragma unroll
                for (int h = 0; h < 4; ++h) { const int bh = b * 4 + h; dsum[h] = (lane < cnt) ? denp[(size_t)(bh * 2048 + s) * 32 + lane] : 0.f; emv[h] = sem[bh * 2048 + s]; }
#pragma unroll
                for (int o = 1; o < 64; o <<= 1) {
#pragma unroll
                    for (int h = 0; h < 4; ++h) dsum[h] += __shfl_xor(dsum[h], o); }
            }
            f32x4 a[4], b2[4]; float ss[4];
#pragma unroll
            for (int h = 0; h < 4; ++h) { a[h] = unlo(raw[h]); b2[h] = unhi(raw[h]);
                if (t < TP) { const float dd = 1.f / fmaxf(fabsf(dsum[h]), emv[h]); a[h] = a[h] * dd; b2[h] = b2[h] * dd; }
                ss[h] = a[h][0] * a[h][0] + a[h][1] * a[h][1] + a[h][2] * a[h][2] + a[h][3] * a[h][3] + b2[h][0] * b2[h][0] + b2[h][1] * b2[h][1] + b2[h][2] * b2[h][2] + b2[h][3] * b2[h][3]; }
#pragma unroll
            for (int o = 1; o < 64; o <<= 1) {
#pragma unroll
                for (int h = 0; h < 4; ++h) ss[h] += __shfl_xor(ss[h], o); }
#pragma unroll
            for (int h = 0; h < 4; ++h) { const float rstd = rsqrtf(ss[h] * (1.f / 512.f) + EPS);
                const f32x4 g0 = *(const f32x4*)(P.g_head + h * 512 + lane * 8), g1 = *(const f32x4*)(P.g_head + h * 512 + lane * 8 + 4);
                *(u32x4*)(bm + (size_t)t * 2048 + h * 512 + lane * 8) = pack8(a[h] * rstd * g0 * unlo(sr[h]), b2[h] * rstd * g1 * unhi(sr[h])); }
        }
        __syncthreads();
        SchedU S1; S1.init(G, bid, ab, 1024, WpaT, 1024, 34, 8, 1024);
        EpiPA E1{T1, ga};
        gemm_phase(lds, 1024, 1024, S1, E1);
        SchedPe S2{G, bid, (const char*)pbf, (const char*)WpleT};
        EpiBf E2{pe, 2048};
        gemm_phase(lds, PLE, PLE, S2, E2);
        {
            const int skip = (272 - G > 0 && 272 - G < G) ? 272 - G : 0;
            if (bid >= skip) { LAS float* scr = (LAS float*)lds + wid * (64 * 33);
                for (int it = W_PB0 + (bid - skip) * 8 + wid; it < W_PB0 + 2048; it += (G - skip) * 8) weight_item(P, it, scr, lane);
                for (int it = 11264 + (bid - skip) * 8 + wid; it < 11264 + 5632; it += (G - skip) * 8) weight_item(P, it, scr, lane); }
        }
    }
    xcd_barrier(xb);

    if constexpr ((PHM >> 5) & 1)
    {
        SchedK S1; S1.init(G, bid, bm, 2048, WpbT, 2048, 34, 8, 2048);
        EpiPB E1{merged, T1, gb};
        gemm_phase(lds, 2048, 2048, S1, E1, part, flags + 1 * 4096, 8u * (REPI + 1));
    }
    xcd_barrier(xb);

    if constexpr ((PHM >> 6) & 1)
    {
        SchedK S1; S1.init(G, bid, merged, 2048, WoutT, 2048, 34, 8, 2048);
        EpiSq E1{tout, ssq};
        gemm_phase(lds, 2048, 2048, S1, E1, part, flags + 2 * 4096, 8u * (REPI + 1));
    }
    xcd_barrier(xb);

    if constexpr ((PHM >> 7) & 1)
    {
        for (int t = gw; t < T; t += NGW) {
            const float* xr = (t < TP) ? P.x_prompt + (size_t)t * DM : P.x_sample + (size_t)(t - TP) * DM;
            float q = (lane < 32) ? ssq[(size_t)t * 32 + lane] : 0.f; q = wave_sum(q); const float rs1 = rsqrtf(q * (1.f / DM) + EPS);
            f32x4 xa[4], xb[4]; float ss = 0.f;
#pragma unroll
            for (int j = 0; j < 4; ++j) { const int c = lane * 8 + 512 * j; const u32x4 raw = *(const u32x4*)(tout + (size_t)t * DM + c);
                const f32x4 g0 = *(const f32x4*)(P.g_post_mix + c), g1 = *(const f32x4*)(P.g_post_mix + c + 4);
                xa[j] = *(const f32x4*)(xr + c) + unlo(raw) * rs1 * g0; xb[j] = *(const f32x4*)(xr + c + 4) + unhi(raw) * rs1 * g1;
                *(u32x4*)(x1b + (size_t)t * DM + c) = pack8(xa[j], xb[j]);
                ss += xa[j][0] * xa[j][0] + xa[j][1] * xa[j][1] + xa[j][2] * xa[j][2] + xa[j][3] * xa[j][3] + xb[j][0] * xb[j][0] + xb[j][1] * xb[j][1] + xb[j][2] * xb[j][2] + xb[j][3] * xb[j][3]; }
            ss = wave_sum(ss); if (lane == 0) rs2b[t] = rsqrtf(ss * (1.f / DM) + EPS);
        }
    }
    xcd_barrier(xb);

    if constexpr ((PHM >> 8) & 1)
    {
        SchedU S1; S1.init(G, bid, x1b, 2048, WguT, 2048, 34, 44, 2048);
        EpiSwi E1{act, rs2b};
        gemm_phase(lds, 2048, 2048, S1, E1);
        {
            const int rem = 1496 % G, nsl = rem ? G - rem : G, sl = rem ? bid - rem : bid;
            if (sl >= 0) { LAS float* scr = (LAS float*)lds + wid * (64 * 33);
                for (int it = W_DN0 + sl * 8 + wid; it < W_DN0 + 5632; it += nsl * 8) weight_item(P, it, scr, lane); }
        }
    }
    xcd_barrier(xb);

    if constexpr ((PHM >> 9) & 1)
    {
        SchedK S1; S1.init(G, bid, act, DFF, WdnT, DFF, 34, 8, DFF);
        EpiSq E1{fout, ssq};
        gemm_phase(lds, DFF, DFF, S1, E1, part, flags + 3 * 4096, 8u * (REPI + 1));
    }
    xcd_barrier(xb);

    if constexpr ((PHM >> 10) & 1)
    {
        for (int t = gw; t < T; t += NGW) {
            float q = (lane < 32) ? ssq[(size_t)t * 32 + lane] : 0.f; q = wave_sum(q); const float rs1 = rsqrtf(q * (1.f / DM) + EPS);
#pragma unroll
            for (int j = 0; j < 4; ++j) { const int c = lane * 8 + 512 * j; const u32x4 raw = *(const u32x4*)(fout + (size_t)t * DM + c);
                const f32x4 g0 = *(const f32x4*)(P.g_post_ffn + c), g1 = *(const f32x4*)(P.g_post_ffn + c + 4);
                const u32x4 xr1 = *(const u32x4*)(x1b + (size_t)t * DM + c);
                const f32x4 a = unlo(xr1) + unlo(raw) * rs1 * g0, b2 = unhi(xr1) + unhi(raw) * rs1 * g1;
                *(u32x4*)(x2b + (size_t)t * DM + c) = pack8(a, b2); }
        }
    }
    xcd_barrier(xb);

    if constexpr ((PHM >> 11) & 1)
    {
        SchedK S1; S1.init(G, bid, x2b, 2048, WpgT, 2048, 34, 8, 2048);
        EpiPle E1{P.out, x2b, pe};
        gemm_phase(lds, 2048, 2048, S1, E1, part, flags + 4 * 4096, 8u * (REPI + 1));
    }
}

#undef WinT
#undef WguT
#undef WdnT
#undef WpaT
#undef WpbT
#undef WoutT
#undef WpgT
#undef WpleT
#undef WgrpT
#undef h1
#undef merged
#undef so
#undef x2b
#undef ga
#undef gb
#undef numb
#undef tout
#undef bm
#undef h2
#undef T1
#undef fout
#undef pe
#undef vs_
#undef ub
#undef qb
#undef kb
#undef zb
#undef ab
#undef vT
#undef kwT
#undef pbf
#undef Sall
#undef act
#undef x1b
#undef rs2b
#undef igp
#undef lfp
#undef su
#undef sw
#undef sem
#undef swkf
#undef denp
#undef ssq
#undef part
#undef flags
#undef barw

extern "C" void kernel_launch(void* const* d_in, const int* in_sizes, int n_in, void* d_out, int out_size, void* d_ws, size_t ws_size, hipStream_t stream) {
    static int grid = 0;
    if (grid == 0) {
        if (n_in != 26 || ws_size < O_END) { fprintf(stderr, "kernel_launch: unexpected n_in %d or workspace %zu < %zu\n", n_in, ws_size, (size_t)O_END); grid = -1; return; }
        int dev = 0, cus = 0, per_cu = 0;
        (void)hipGetDevice(&dev);
        (void)hipDeviceGetAttribute(&cus, hipDeviceAttributeMultiprocessorCount, dev);
        if (hipFuncSetAttribute((const void*)mega, hipFuncAttributeMaxDynamicSharedMemorySize, LDS_BYTES) != hipSuccess) { fprintf(stderr, "kernel_launch: hipFuncSetAttribute failed\n"); grid = -1; return; }
        if (hipOccupancyMaxActiveBlocksPerMultiprocessor(&per_cu, (const void*)mega, 512, LDS_BYTES) != hipSuccess || per_cu < 1) { fprintf(stderr, "kernel_launch: occupancy query gave %d\n", per_cu); per_cu = 1; }
        (void)hipGetLastError();
        grid = cus * 1;
        if (grid > 256) grid = 256;
    }
    if (grid < 0) return;
    Params p{};
    const float** pp = (const float**)&p;
    for (int i = 0; i < 26; ++i) pp[i] = (const float*)d_in[i];
    p.out = (float*)d_out; p.ws = (unsigned char*)d_ws;
    void* args[] = {&p};
    hipError_t e = hipLaunchCooperativeKernel((const void*)mega, dim3(grid), dim3(512), args, LDS_BYTES, stream);
    if (e != hipSuccess) fprintf(stderr, "cooperative launch failed: %s (grid %d)\n", hipGetErrorString(e), grid);
}
```

```cpp
#include <hip/hip_runtime.h>
#include <hip/hip_cooperative_groups.h>
#include <cstdio>
namespace cg = cooperative_groups;

#define LAS __attribute__((address_space(3)))
typedef unsigned short bf16_t;
typedef short bf16x8 __attribute__((ext_vector_type(8)));
typedef float f32x4 __attribute__((ext_vector_type(4)));
typedef unsigned u32x4 __attribute__((ext_vector_type(4)));
typedef unsigned u32x2 __attribute__((ext_vector_type(2)));

constexpr int T = 8704, TP = 8192, TS = 512, DM = 2048, NIN = 11272, NP = 11264, DP = 1024, HQK = 1024, HV = 2048, DFF = 5632, PLE = 256;
constexpr float EPS = 1e-6f, LOG2E = 1.4426950408889634f;
constexpr size_t OUT_YS = (size_t)TP * DM, OUT_POOLP = OUT_YS + (size_t)TS * DM, OUT_CP = OUT_POOLP + 4 * 15 * 1024,
                 OUT_NP = OUT_CP + (size_t)16 * 256 * 512, OUT_MP = OUT_NP + 16 * 256, OUT_POOLS = OUT_MP + 16,
                 OUT_CS = OUT_POOLS + (size_t)128 * 15 * 1024, OUT_NS = OUT_CS + (size_t)512 * 256 * 512, OUT_MS = OUT_NS + 512 * 256;
constexpr size_t O_WIN = 0;
constexpr size_t O_WGU = O_WIN + (size_t)NP * DM * 2;
constexpr size_t O_WDN = O_WGU + (size_t)NP * DM * 2;
constexpr size_t O_WPA = O_WDN + (size_t)DM * DFF * 2;
constexpr size_t O_WPB = O_WPA + (size_t)DM * DP * 2;
constexpr size_t O_WOUT = O_WPB + (size_t)DM * DM * 2;
constexpr size_t O_WPG = O_WOUT + (size_t)DM * DM * 2;
constexpr size_t O_WPLE = O_WPG + (size_t)DM * DM * 2;
constexpr size_t O_WGRP = O_WPLE + (size_t)DM * PLE * 2;
constexpr size_t O_H1 = O_WGRP + (size_t)DP * 256 * 2;
constexpr size_t O_SO = O_H1 + (size_t)T * DM * 2;
constexpr size_t O_GA = O_SO + (size_t)T * DM * 2;
constexpr size_t O_GB = O_GA + (size_t)T * DM * 2;
constexpr size_t O_NUM = O_GB + (size_t)T * DM * 2;
constexpr size_t O_BM = O_NUM + (size_t)T * DM * 2;
constexpr size_t O_T1 = O_BM + (size_t)T * DM * 2;
constexpr size_t O_PE = O_T1 + (size_t)T * DM * 2;
constexpr size_t O_V = O_PE + (size_t)T * DM * 2;
constexpr size_t O_U = O_V + (size_t)TS * HV * 2;
constexpr size_t O_Q = O_U + (size_t)T * 1024 * 2;
constexpr size_t O_K = O_Q + (size_t)T * 1024 * 2;
constexpr size_t O_Z = O_K + (size_t)T * 1024 * 2;
constexpr size_t O_A = O_Z + (size_t)T * 1024 * 2;
constexpr size_t O_VT = O_A + (size_t)T * 1024 * 2;
constexpr size_t O_KWT = O_VT + (size_t)HV * TP * 2;
constexpr size_t O_PBF = O_KWT + (size_t)HQK * TP * 2;
constexpr size_t O_S = O_PBF + (size_t)T * PLE * 2;
constexpr size_t O_X1 = O_S + (size_t)TP * 8192 * 2;
constexpr size_t O_IG = O_X1 + (size_t)T * DM * 4;
constexpr size_t O_LF = O_IG + (size_t)T * 4 * 4;
constexpr size_t O_SU = O_LF + (size_t)T * 4 * 4;
constexpr size_t O_SW = O_SU + 16 * 2048 * 4;
constexpr size_t O_SEM = O_SW + 16 * 2048 * 4;
constexpr size_t O_SWKF = O_SEM + 16 * 2048 * 4;
constexpr size_t O_DENP = O_SWKF + 16 * 2048 * 4;
constexpr size_t O_SSQ = O_DENP + (size_t)16 * 2048 * 32 * 4;
constexpr size_t O_FLAG = O_SSQ + (size_t)T * 32 * 4;
constexpr size_t O_BAR = O_FLAG + 1024 * 64 * 4;
constexpr size_t O_PART = O_BAR + 16384;
constexpr size_t O_END = O_PART + (size_t)256 * 32 * 512 * 16;
static_assert((size_t)T * DFF * 2 <= (size_t)TP * 8192 * 2, "act alias");

constexpr int LDS_BYTES = 147456;
#ifndef REP_PHASE
#define REP_PHASE -1
#define REP_N 1
#define REPI 0
#endif
#ifndef P2M
#define P2M 15
#endif
#ifndef PHM
#define PHM 0xFFF
#endif

struct Params {
    const float *x_prompt, *x_sample, *p_prompt, *p_sample, *state_pool, *state_C, *state_n, *state_m, *g_pre_mix, *w_in, *b_i, *b_f,
        *w_pool_grp, *s_pool, *g_head, *w_pa, *w_pb, *w_out, *g_post_mix, *g_pre_ffn, *w_gate, *w_up, *w_down, *g_post_ffn, *w_ple, *w_ple_gate;
    float* out;
    unsigned char* ws;
};

__device__ __forceinline__ unsigned pk2(float lo, float hi) { unsigned r; asm("v_cvt_pk_bf16_f32 %0, %1, %2" : "=v"(r) : "v"(lo), "v"(hi)); return r; }
__device__ __forceinline__ float bflo(unsigned w) { return __uint_as_float(w << 16); }
__device__ __forceinline__ float bfhi(unsigned w) { return __uint_as_float(w & 0xffff0000u); }
__device__ __forceinline__ float bf1(bf16_t v) { return __uint_as_float(((unsigned)v) << 16); }
__device__ __forceinline__ float wave_sum(float v) {
#pragma unroll
    for (int o = 1; o < 64; o <<= 1) v += __shfl_xor(v, o);
    return v;
}
__device__ __forceinline__ float fsigmoid(float x) { return __builtin_amdgcn_rcpf(1.0f + __builtin_amdgcn_exp2f(-x * LOG2E)); }
__device__ __forceinline__ u32x4 pack8(const f32x4 v0, const f32x4 v1) { u32x4 w; w.x = pk2(v0[0], v0[1]); w.y = pk2(v0[2], v0[3]); w.z = pk2(v1[0], v1[1]); w.w = pk2(v1[2], v1[3]); return w; }
__device__ __forceinline__ f32x4 unlo(const u32x4 w) { return (f32x4){bflo(w.x), bfhi(w.x), bflo(w.y), bfhi(w.y)}; }
__device__ __forceinline__ f32x4 unhi(const u32x4 w) { return (f32x4){bflo(w.z), bfhi(w.z), bflo(w.w), bfhi(w.w)}; }
__device__ __forceinline__ f32x4 sig4(f32x4 v) { return (f32x4){fsigmoid(v[0]), fsigmoid(v[1]), fsigmoid(v[2]), fsigmoid(v[3])}; }
#define LDS_WAIT() asm volatile("s_waitcnt lgkmcnt(0)" ::: "memory")

constexpr int BK = 64, HALF = 128, HTB = HALF * BK * 2;
__device__ __forceinline__ int lds_byte(int r, int c) { const int st = (r >> 4) * 2 + (c >> 5), rr = r & 15, cc = c & 31, ob = rr * 64 + cc * 2; return st * 1024 + (ob ^ (((ob >> 9) & 1) << 5)); }
__device__ __forceinline__ void stage_rc(int b, int& R, int& C) { const int st = b / 1024, sb = b % 1024, swz = sb ^ (((sb >> 9) & 1) << 5); R = (st >> 1) * 16 + swz / 64; C = (st & 1) * 32 + (swz % 64) / 2; }
__device__ __forceinline__ int perm32(int rho) { const int n = rho >> 4, i = rho & 15; return 8 * (i >> 2) + 4 * n + (i & 3); }

struct Unit { const char* A; const char* B; int nt, pm, pn, z, mode, slot; };

__device__ __forceinline__ int xcd_remap(int L, int nwg) { const int q = nwg / 8, r = nwg % 8, xcd = L % 8, off = L / 8; return (xcd < r ? xcd * (q + 1) : r * (q + 1) + (xcd - r) * q) + off; }
__device__ __forceinline__ void grouped(int w, int nM, int nN, int& pm, int& pn) { const int nig = 8 * nN, gid = w / nig, fm = gid * 8, gsz = (nM - fm) < 8 ? (nM - fm) : 8; pm = fm + ((w % nig) % gsz); pn = (w % nig) / gsz; }

template <class Sched, class Epi>
__device__ __forceinline__ void gemm_phase(LAS unsigned char* lds, const int lda, const int ldb, const Sched& S, const Epi& E, float* part = nullptr, unsigned* flags = nullptr, unsigned target = 0u) {
    const int tid = threadIdx.x, wid = __builtin_amdgcn_readfirstlane(tid >> 6), lane = tid & 63, wr = wid >> 2, wc = wid & 3, fr = lane & 15, fq = lane >> 4;
    unsigned voffA[2], voffB[2];
#pragma unroll
    for (int i = 0; i < 2; ++i) { int R, C; stage_rc(tid * 16 + i * 8192, R, C); const int Rb = (R & ~31) + perm32(R & 31);
        voffA[i] = (unsigned)(R * lda + C) * 2u; voffB[i] = (unsigned)(Rb * ldb + C) * 2u; }
    const size_t kstep = (size_t)(BK * 2);
    const size_t hstepA = (size_t)HALF * lda * 2, hstepB = (size_t)HALF * ldb * 2;
    const unsigned ldsw = (unsigned)wid * 1024u;
    const int aoff = lds_byte(wr * 64 + fr, fq * 8), boff = lds_byte(wc * 32 + fr, fq * 8);
#define PG8_SA(b, h) (((b) * 2 + (h)) * HTB)
#define PG8_SB(b, h) ((4 + (b) * 2 + (h)) * HTB)
#define PG8_STAGE(bufoff, gbase, voff) do { _Pragma("unroll") for (int _i = 0; _i < 2; ++_i) \
        __builtin_amdgcn_global_load_lds((const unsigned*)((const char*)(gbase) + (voff)[_i]), (LAS unsigned*)(lds + (bufoff) + ldsw + _i * 8192), 16, 0, 0); } while (0)
#define PG8_LDA(dst, b, h) do { _Pragma("unroll") for (int m = 0; m < 4; ++m) _Pragma("unroll") for (int k = 0; k < 2; ++k) dst[m][k] = *(const LAS bf16x8*)(lds + PG8_SA(b, h) + aoff + m * 2048 + k * 1024); } while (0)
#define PG8_LDB(dst, b, h) do { _Pragma("unroll") for (int n = 0; n < 2; ++n) _Pragma("unroll") for (int k = 0; k < 2; ++k) dst[n][k] = *(const LAS bf16x8*)(lds + PG8_SB(b, h) + boff + n * 2048 + k * 1024); } while (0)
#define PG8_MMA(ai, bj, At, Bt) do { __builtin_amdgcn_s_setprio(1); _Pragma("unroll") for (int m = 0; m < 4; ++m) _Pragma("unroll") for (int n = 0; n < 2; ++n) _Pragma("unroll") for (int k = 0; k < 2; ++k) \
        acc[ai][bj][m][n] = __builtin_amdgcn_mfma_f32_16x16x32_bf16(Bt[n][k], At[m][k], acc[ai][bj][m][n], 0, 0, 0); __builtin_amdgcn_s_setprio(0); } while (0)
#define PG8_WAIT_V(n) asm volatile("s_waitcnt vmcnt(" #n ")" ::: "memory")
#define PG8_WAIT_L(n) asm volatile("s_waitcnt lgkmcnt(" #n ")" ::: "memory")
#define PG8_BAR __builtin_amdgcn_s_barrier()
#define PG8_SCHED __builtin_amdgcn_sched_barrier(0)
    Unit cur, nxt; int ui = 0;
    if (!S.next(0, cur)) return;
    f32x4 acc[2][2][4][2];
#pragma unroll
    for (int a = 0; a < 2; ++a)
#pragma unroll
        for (int b = 0; b < 2; ++b)
#pragma unroll
            for (int m = 0; m < 4; ++m)
#pragma unroll
                for (int n = 0; n < 2; ++n) acc[a][b][m][n] = (f32x4){0.f, 0.f, 0.f, 0.f};
    bf16x8 At[4][2], B0[2][2], B1[2][2];
    const char* cA = cur.A; const char* cB = cur.B;
    PG8_STAGE(PG8_SB(0, 0), cB, voffB); PG8_STAGE(PG8_SA(0, 0), cA, voffA); PG8_STAGE(PG8_SB(0, 1), cB + hstepB, voffB); PG8_STAGE(PG8_SA(0, 1), cA + hstepA, voffA);
    if (wr == 1) PG8_BAR;
    PG8_WAIT_V(4); PG8_BAR;
    PG8_STAGE(PG8_SB(1, 0), cB + kstep, voffB); PG8_STAGE(PG8_SA(1, 0), cA + kstep, voffA); PG8_STAGE(PG8_SB(1, 1), cB + hstepB + kstep, voffB);
    PG8_WAIT_V(6); PG8_BAR;
    for (;;) {
        const bool has_next = S.next(ui + 1, nxt);
        const char* nA = has_next ? nxt.A : cA; const char* nB = has_next ? nxt.B : cB;
        int nt = cur.nt; asm volatile("" : "+s"(nt));
        for (int t = 0; t < nt; t += 2) {
            const bool last = (t == nt - 2);
            const char* a1 = cA + (size_t)(t + 1) * kstep;
            const char* a2 = last ? nA : cA + (size_t)(t + 2) * kstep; const char* b2 = last ? nB : cB + (size_t)(t + 2) * kstep;
            asm volatile("" : "+s"(a1), "+s"(a2), "+s"(b2));
            const char* a3 = a2 + kstep; const char* b3 = b2 + kstep;
            PG8_LDB(B0, 0, 0); PG8_SCHED; PG8_LDA(At, 0, 0); PG8_STAGE(PG8_SA(1, 1), a1 + hstepA, voffA);
            PG8_WAIT_L(8); PG8_BAR; PG8_WAIT_L(0); PG8_MMA(0, 0, At, B0); PG8_BAR; PG8_SCHED;
            PG8_LDB(B1, 0, 1); PG8_STAGE(PG8_SB(0, 0), b2, voffB);
            PG8_BAR; PG8_WAIT_L(0); PG8_MMA(0, 1, At, B1); PG8_BAR;
            PG8_LDA(At, 0, 1); PG8_STAGE(PG8_SA(0, 0), a2, voffA);
            PG8_BAR; PG8_WAIT_L(0); PG8_MMA(1, 0, At, B0); PG8_BAR; PG8_SCHED;
            PG8_STAGE(PG8_SB(0, 1), b2 + hstepB, voffB);
            PG8_WAIT_V(6); PG8_BAR; PG8_MMA(1, 1, At, B1); PG8_BAR;
            PG8_LDB(B0, 1, 0); PG8_SCHED; PG8_LDA(At, 1, 0); PG8_STAGE(PG8_SA(0, 1), a2 + hstepA, voffA);
            PG8_WAIT_L(8); PG8_BAR; PG8_WAIT_L(0); PG8_MMA(0, 0, At, B0); PG8_BAR; PG8_SCHED;
            PG8_LDB(B1, 1, 1); PG8_STAGE(PG8_SB(1, 0), b3, voffB);
            PG8_BAR; PG8_WAIT_L(0); PG8_MMA(0, 1, At, B1); PG8_BAR;
            PG8_LDA(At, 1, 1); PG8_STAGE(PG8_SA(1, 0), a3, voffA);
            PG8_BAR; PG8_WAIT_L(0); PG8_MMA(1, 0, At, B0); PG8_BAR; PG8_SCHED;
            PG8_STAGE(PG8_SB(1, 1), b3 + hstepB, voffB);
            PG8_WAIT_V(6); PG8_BAR; PG8_MMA(1, 1, At, B1); PG8_BAR;
        }
        if constexpr (Sched::SK) {
            if (cur.mode == 2) {
                while (__hip_atomic_load(flags + cur.slot * 16, __ATOMIC_RELAXED, __HIP_MEMORY_SCOPE_AGENT) < target) __builtin_amdgcn_s_sleep(2);
                const __amdgpu_buffer_rsrc_t rl_ = __builtin_amdgcn_make_buffer_rsrc((void*)((char*)part + (size_t)cur.slot * 131072), (short)0, 131072, 0x00020000);
#pragma unroll
                for (int a = 0; a < 2; ++a) {
                    u32x4 tmp[8];
#pragma unroll
                    for (int j = 0; j < 8; ++j) tmp[j] = __builtin_amdgcn_raw_buffer_load_b128(rl_, tid * 16, (a * 8 + j) * 8192, 16);
                    asm volatile("s_waitcnt vmcnt(0)" ::: "memory");
#pragma unroll
                    for (int j = 0; j < 8; ++j) { acc[a][j >> 2][j & 3][0] += unlo(tmp[j]); acc[a][j >> 2][j & 3][1] += unhi(tmp[j]); }
                    __builtin_amdgcn_sched_barrier(0);
                }
            }
            __builtin_amdgcn_sched_barrier(0);
            if (cur.mode == 1) {
                const __amdgpu_buffer_rsrc_t rs = __builtin_amdgcn_make_buffer_rsrc((void*)((char*)part + (size_t)cur.slot * 131072), (short)0, 131072, 0x00020000);
#pragma unroll
                for (int a = 0; a < 2; ++a)
#pragma unroll
                    for (int b = 0; b < 2; ++b)
#pragma unroll
                        for (int m = 0; m < 4; ++m)
                            __builtin_amdgcn_raw_buffer_store_b128(pack8(acc[a][b][m][0], acc[a][b][m][1]), rs, tid * 16, ((a * 2 + b) * 4 + m) * 8192, 16);
                asm volatile("s_waitcnt vmcnt(0)" ::: "memory");
                if (lane == 0) __hip_atomic_fetch_add(flags + cur.slot * 16, 1u, __ATOMIC_RELAXED, __HIP_MEMORY_SCOPE_AGENT);
            } else {
                E(acc, cur, wr, wc, fr, fq);
            }
        } else {
            E(acc, cur, wr, wc, fr, fq);
        }
        if (!has_next) break;
#pragma unroll
        for (int a = 0; a < 2; ++a)
#pragma unroll
            for (int b = 0; b < 2; ++b)
#pragma unroll
                for (int m = 0; m < 4; ++m)
#pragma unroll
                    for (int n = 0; n < 2; ++n) acc[a][b][m][n] = (f32x4){0.f, 0.f, 0.f, 0.f};
        cur = nxt; cA = nA; cB = nB; ++ui;
    }
    PG8_WAIT_V(0);
    if (wr == 0) PG8_BAR;
    PG8_BAR;
#undef PG8_SA
#undef PG8_SB
#undef PG8_STAGE
#undef PG8_LDA
#undef PG8_LDB
#undef PG8_MMA
#undef PG8_WAIT_V
#undef PG8_WAIT_L
#undef PG8_BAR
#undef PG8_SCHED
}

typedef f32x4 Acc[2][2][4][2];

struct SchedU {
    static constexpr bool SK = false;
    int G, c, nM, nN, nt; const char* A; const char* B; size_t tA, tB;
    __device__ __forceinline__ void init(int G_, int c_, const void* A_, int lda, const void* B_, int ldb, int nM_, int nN_, int K) {
        G = G_; c = c_; nM = nM_; nN = nN_; nt = K / BK; A = (const char*)A_; B = (const char*)B_; tA = (size_t)256 * lda * 2; tB = (size_t)256 * ldb * 2; }
    __device__ __forceinline__ bool next(int i, Unit& u) const { u.mode = 0; u.slot = 0;
        const int nwg = nM * nN; const long L = (long)i * G + c; if (L >= nwg) return false;
        const int w = xcd_remap((int)L, nwg); int pm, pn; grouped(w, nM, nN, pm, pn);
        u.A = A + (size_t)pm * tA; u.B = B + (size_t)pn * tB; u.nt = nt; u.pm = pm; u.pn = pn; u.z = 0; return true; }
};
struct SchedK {
    static constexpr bool SK = true;
    int nM, nN, n; const char* A; const char* B; size_t tA, tB; int s0, s1, cpos;
    __device__ __forceinline__ void init(int G, int bid, const void* A_, int lda, const void* B_, int ldb, int nM_, int nN_, int K) {
        nM = nM_; nN = nN_; n = K / (2 * BK); A = (const char*)A_; B = (const char*)B_; tA = (size_t)256 * lda * 2; tB = (size_t)256 * ldb * 2;
        cpos = (G % 8 == 0) ? (bid % 8) * (G / 8) + bid / 8 : bid;
        const long TT = (long)nM * nN * n; s0 = (int)((long)cpos * TT / G); s1 = (int)((long)(cpos + 1) * TT / G); }
    __device__ __forceinline__ void piece(Unit& u, int ui, int t0, int nt_, int mode, int slot) const {
        int pm, pn; grouped(ui, nM, nN, pm, pn);
        u.A = A + (size_t)pm * tA + (size_t)t0 * (4 * BK); u.B = B + (size_t)pn * tB + (size_t)t0 * (4 * BK); u.nt = 2 * nt_; u.pm = pm; u.pn = pn; u.z = 0; u.mode = mode; u.slot = slot; }
    __device__ __forceinline__ bool next(int i, Unit& u) const {
        const int u0 = s0 / n, o0 = s0 % n, u1 = s1 / n, e = s1 % n, fstart = (o0 > 0) ? u0 + 1 : u0, nfull = u1 - fstart;
        int k = i;
        if (e > 0) { if (k == 0) { piece(u, u1, 0, e, 1, cpos); return true; } --k; }
        if (k < nfull) { piece(u, fstart + k, 0, n, 0, 0); return true; }
        k -= nfull;
        if (o0 > 0 && k == 0) { piece(u, u0, o0, n - o0, 2, cpos - 1); return true; }
        return false; }
};
struct SchedP1 {
    static constexpr bool SK = false;
    int G, c; const char* h1; const char* WinT;
    __device__ __forceinline__ bool next(int i, Unit& u) const { u.mode = 0; u.slot = 0;
        const int nwg = 1496; const long L = (long)i * G + c; if (L >= nwg) return false;
        int w = xcd_remap((int)L, nwg); int pm, pn; const size_t ts = (size_t)256 * 2048 * 2;
        u.nt = 32; u.z = 0;
        { const int x = w / 187, o = w % 187;
          if (o < 48) w = 48 * x + o; else if (o < 144) w = 384 + 96 * x + (o - 48); else if (o < 176) w = 1240 + 32 * x + (o - 144); else w = 1152 + 11 * x + (o - 176); }
        if (w < 384) { grouped(w, 32, 12, pm, pn); }
        else if (w < 1152) { grouped(w - 384, 32, 24, pm, pn); pn += 20; }
        else if (w < 1240) { grouped(w - 1152, 2, 44, pm, pn); pm += 32; }
        else { grouped(w - 1240, 8, 32, pm, pn); u.z = 1; u.A = WinT + (size_t)(12 + pm) * ts; u.B = h1 + (size_t)pn * ts; u.pm = pm; u.pn = pn; return true; }
        u.A = h1 + (size_t)pm * ts; u.B = WinT + (size_t)pn * ts; u.pm = pm; u.pn = pn; return true; }
};
struct SchedQK {
    static constexpr bool SK = false;
    int G, c; const char* q; const char* k;
    __device__ __forceinline__ bool next(int i, Unit& u) const { u.mode = 0; u.slot = 0;
        const long L = (long)i * G + c; if (L >= 576) return false;
        const int bh = (int)L / 36, tri = (int)L % 36; int pm = 0, rem = tri;
        while (rem > pm) { rem -= pm + 1; ++pm; }
        const int pn = rem, b = bh >> 2, h = bh & 3;
        u.A = q + ((size_t)(b * 2048 + pm * 256) * 1024 + h * 256) * 2; u.B = k + ((size_t)(b * 2048 + pn * 256) * 1024 + h * 256) * 2;
        u.nt = 4; u.pm = pm; u.pn = pn; u.z = bh; return true; }
};
struct SchedSV {
    static constexpr bool SK = false;
    int G, c; const char* S; const char* vT; const char* kwT;
    __device__ __forceinline__ bool next(int i, Unit& u) const { u.mode = 0; u.slot = 0;
        if ((long)i * G >= 288) return false;
        const int o = (i & 1) ? (i * G + (G - 1 - c)) : (i * G + c); if (o >= 288) return false;
        if (o < 32) { const int bh = o >> 1, pn = o & 1, b = bh >> 2, h = bh & 3;
            u.A = kwT + ((size_t)(h * 256) * TP + b * 2048) * 2; u.B = vT + ((size_t)(h * 512 + pn * 256) * TP + b * 2048) * 2; u.nt = 32; u.pm = 0; u.pn = pn; u.z = 16 + bh; return true; }
        const int o2 = o - 32, pm = 7 - (o2 >> 5), rem = o2 & 31, bh = rem >> 1, pn = rem & 1, b = bh >> 2, h = bh & 3;
        u.A = S + ((size_t)(b * 2048 + pm * 256) * 8192 + h * 2048) * 2; u.B = vT + ((size_t)(h * 512 + pn * 256) * TP + b * 2048) * 2; u.nt = 4 * (pm + 1); u.pm = pm; u.pn = pn; u.z = bh; return true; }
};
struct SchedPool {
    static constexpr bool SK = false;
    int G, c; const char* zb; const char* Wg;
    __device__ __forceinline__ bool next(int i, Unit& u) const { u.mode = 0; u.slot = 0;
        const long L = (long)i * G + c; if (L >= 136) return false;
        const int g = (int)L / 34, pm = (int)L % 34;
        u.A = zb + ((size_t)pm * 256 * 1024 + g * 256) * 2; u.B = Wg + (size_t)g * 65536 * 2; u.nt = 4; u.pm = pm; u.pn = 0; u.z = g; return true; }
};

struct SchedPe {
    static constexpr bool SK = false;
    int G, c; const char* p; const char* W;
    __device__ __forceinline__ bool next(int i, Unit& u) const { u.mode = 0; u.slot = 0;
        const int skip = (272 - G > 0 && 272 - G < G) ? 272 - G : 0; if (c < skip) return false;
        const long L = (long)i * (G - skip) + (c - skip); if (L >= 272) return false;
        const int pm = (int)L % 34, pn = (int)L / 34;
        u.A = p + (size_t)pm * 256 * PLE * 2; u.B = W + (size_t)pn * 256 * PLE * 2; u.nt = 4; u.pm = pm; u.pn = pn; u.z = 0; return true; }
};

#define EPI_LAUNDER int lr_ = 64 * wr + fr, lc_ = 32 * wc + 8 * fq; asm volatile("" : "+v"(lr_), "+v"(lc_));
#define EPI_ROWS_BEGIN _Pragma("unroll") for (int ai = 0; ai < 2; ++ai) _Pragma("unroll") for (int m = 0; m < 4; ++m) { const int rl = 128 * ai + 16 * m + lr_;
#define EPI_ROWS_END }

struct EpiP1 {
    bf16_t *u, *q, *k, *v, *so, *ga, *gb, *vT;
    __device__ __forceinline__ void operator()(const Acc& acc, const Unit& un, int wr, int wc, int fr, int fq) const { EPI_LAUNDER
        bf16_t* dst; int ldc; float scale = 1.f; bool sg = false; long row0 = (long)un.pm * 256;
        if (un.z == 1) { dst = vT + un.pn * 256; ldc = TP; }
        else { const int tn = un.pn;
            if (tn < 4) { dst = u + tn * 256; ldc = 1024; }
            else if (tn < 8) { dst = q + (tn - 4) * 256; ldc = 1024; }
            else if (tn < 12) { dst = k + (tn - 8) * 256; ldc = 1024; scale = 0.0625f; }
            else if (tn < 20) { dst = v + (tn - 12) * 256; ldc = 2048; row0 -= TP; }
            else if (tn < 28) { dst = so + (tn - 20) * 256; ldc = 2048; }
            else if (tn < 36) { dst = ga + (tn - 28) * 256; ldc = 2048; sg = true; }
            else { dst = gb + (tn - 36) * 256; ldc = 2048; sg = true; } }
        const int cl0 = lc_;
        EPI_ROWS_BEGIN
            bf16_t* rp = dst + (size_t)(row0 + rl) * ldc + cl0;
#pragma unroll
            for (int bj = 0; bj < 2; ++bj) { f32x4 v0 = acc[ai][bj][m][0], v1 = acc[ai][bj][m][1];
                if (sg) { v0 = sig4(v0); v1 = sig4(v1); } else { v0 = v0 * scale; v1 = v1 * scale; }
                *(u32x4*)(rp + bj * HALF) = pack8(v0, v1); }
        EPI_ROWS_END
    }
};
struct EpiBf {
    bf16_t* dst; int ldc;
    __device__ __forceinline__ void operator()(const Acc& acc, const Unit& un, int wr, int wc, int fr, int fq) const { EPI_LAUNDER
        bf16_t* d0 = dst + (size_t)un.pm * 256 * ldc + un.pn * 256 + lc_;
        EPI_ROWS_BEGIN
            bf16_t* rp = d0 + (size_t)rl * ldc;
#pragma unroll
            for (int bj = 0; bj < 2; ++bj) *(u32x4*)(rp + bj * HALF) = pack8(acc[ai][bj][m][0], acc[ai][bj][m][1]);
        EPI_ROWS_END
    }
};
struct EpiS {
    bf16_t* S; const float* su; const float* sw; float* denp;
    __device__ __forceinline__ void operator()(const Acc& acc, const Unit& un, int wr, int wc, int fr, int fq) const { EPI_LAUNDER
        const int bh = un.z, b = bh >> 2, h = bh & 3; const bool diag = (un.pm == un.pn);
        const int cl0 = lc_;
        f32x4 ww[2][2];
#pragma unroll
        for (int bj = 0; bj < 2; ++bj)
#pragma unroll
            for (int n = 0; n < 2; ++n) ww[bj][n] = *(const f32x4*)(sw + bh * 2048 + un.pn * 256 + bj * HALF + cl0 + 4 * n);
        float uu8[2][4];
#pragma unroll
        for (int ai = 0; ai < 2; ++ai)
#pragma unroll
            for (int m = 0; m < 4; ++m) uu8[ai][m] = su[bh * 2048 + un.pm * 256 + 128 * ai + 16 * m + lr_];
        EPI_ROWS_BEGIN
            const int srow = un.pm * 256 + rl; const float uu = uu8[ai][m]; float rs = 0.f; const int lim = diag ? rl : 0x7fffffff;
            bf16_t* rp = S + (size_t)(b * 2048 + srow) * 8192 + h * 2048 + un.pn * 256 + cl0;
#pragma unroll
            for (int bj = 0; bj < 2; ++bj) { f32x4 o[2];
#pragma unroll
                for (int n = 0; n < 2; ++n)
#pragma unroll
                    for (int e = 0; e < 4; ++e) { float val = acc[ai][bj][m][n][e] * __builtin_amdgcn_exp2f(uu + ww[bj][n][e]);
                        if (bj * HALF + cl0 + 4 * n + e > lim) val = 0.f;
                        o[n][e] = val; rs += val; }
                *(u32x4*)(rp + bj * HALF) = pack8(o[0], o[1]); }
            rs += __shfl_xor(rs, 16); rs += __shfl_xor(rs, 32);
            if (fq == 0) denp[(size_t)(bh * 2048 + srow) * 32 + un.pn * 4 + wc] = rs;
        EPI_ROWS_END
    }
};
struct EpiSV {
    bf16_t* num; float* Cp;
    __device__ __forceinline__ void operator()(const Acc& acc, const Unit& un, int wr, int wc, int fr, int fq) const { EPI_LAUNDER
        const int cl0 = lc_;
        if (un.z < 16) { const int bh = un.z, b = bh >> 2, h = bh & 3;
            bf16_t* d0 = num + (size_t)(b * 2048 + un.pm * 256) * 2048 + h * 512 + un.pn * 256 + cl0;
            EPI_ROWS_BEGIN
                bf16_t* rp = d0 + (size_t)rl * 2048;
#pragma unroll
                for (int bj = 0; bj < 2; ++bj) *(u32x4*)(rp + bj * HALF) = pack8(acc[ai][bj][m][0], acc[ai][bj][m][1]);
            EPI_ROWS_END
        } else { const int bh = un.z - 16;
            float* d0 = Cp + (size_t)bh * 256 * 512 + un.pn * 256 + cl0;
            EPI_ROWS_BEGIN
                float* rp = d0 + (size_t)rl * 512;
#pragma unroll
                for (int bj = 0; bj < 2; ++bj) { *(f32x4*)(rp + bj * HALF) = acc[ai][bj][m][0]; *(f32x4*)(rp + bj * HALF + 4) = acc[ai][bj][m][1]; }
            EPI_ROWS_END
        }
    }
};
struct EpiPool {
    bf16_t* a; const float* sp;
    __device__ __forceinline__ void operator()(const Acc& acc, const Unit& un, int wr, int wc, int fr, int fq) const { EPI_LAUNDER
        const int c0 = un.z * 256 + lc_;
        f32x4 s[2][2];
#pragma unroll
        for (int bj = 0; bj < 2; ++bj)
#pragma unroll
            for (int n = 0; n < 2; ++n) s[bj][n] = *(const f32x4*)(sp + c0 + bj * HALF + 4 * n);
        EPI_ROWS_BEGIN
            bf16_t* rp = a + (size_t)(un.pm * 256 + rl) * 1024 + c0;
#pragma unroll
            for (int bj = 0; bj < 2; ++bj) *(u32x4*)(rp + bj * HALF) = pack8(acc[ai][bj][m][0] * s[bj][0], acc[ai][bj][m][1] * s[bj][1]);
        EPI_ROWS_END
    }
};
struct EpiPA {
    bf16_t* T1; const bf16_t* ga;
    __device__ __forceinline__ void operator()(const Acc& acc, const Unit& un, int wr, int wc, int fr, int fq) const { EPI_LAUNDER
        const size_t o0 = (size_t)un.pm * 256 * 2048 + un.pn * 256 + lc_;
        u32x4 gg[2][4][2];
#pragma unroll
        for (int ai = 0; ai < 2; ++ai)
#pragma unroll
            for (int m = 0; m < 4; ++m)
#pragma unroll
                for (int bj = 0; bj < 2; ++bj) gg[ai][m][bj] = *(const u32x4*)(ga + o0 + (size_t)(128 * ai + 16 * m + lr_) * 2048 + bj * HALF);
        EPI_ROWS_BEGIN
            const size_t ro = o0 + (size_t)rl * 2048;
#pragma unroll
            for (int bj = 0; bj < 2; ++bj) { const u32x4 g = gg[ai][m][bj];
                *(u32x4*)(T1 + ro + bj * HALF) = pack8(acc[ai][bj][m][0] * unlo(g), acc[ai][bj][m][1] * unhi(g)); }
        EPI_ROWS_END
    }
};
struct EpiPB {
    bf16_t* mg; const bf16_t* T1; const bf16_t* gb;
    __device__ __forceinline__ void operator()(const Acc& acc, const Unit& un, int wr, int wc, int fr, int fq) const { EPI_LAUNDER
        const size_t o0 = (size_t)un.pm * 256 * 2048 + un.pn * 256 + lc_;
#pragma unroll
        for (int ai = 0; ai < 2; ++ai) {
            u32x4 g4[4][2], t4[4][2];
#pragma unroll
            for (int m = 0; m < 4; ++m)
#pragma unroll
                for (int bj = 0; bj < 2; ++bj) { const size_t ro = o0 + (size_t)(128 * ai + 16 * m + lr_) * 2048 + bj * HALF; g4[m][bj] = *(const u32x4*)(gb + ro); t4[m][bj] = *(const u32x4*)(T1 + ro); }
            __builtin_amdgcn_sched_barrier(0);
#pragma unroll
            for (int m = 0; m < 4; ++m) { const size_t ro = o0 + (size_t)(128 * ai + 16 * m + lr_) * 2048;
#pragma unroll
                for (int bj = 0; bj < 2; ++bj) *(u32x4*)(mg + ro + bj * HALF) = pack8(unlo(t4[m][bj]) + acc[ai][bj][m][0] * unlo(g4[m][bj]), unhi(t4[m][bj]) + acc[ai][bj][m][1] * unhi(g4[m][bj]));
                __builtin_amdgcn_sched_barrier(0); }
        }
    }
};
struct EpiSq {
    bf16_t* dst; float* ssq;
    __device__ __forceinline__ void operator()(const Acc& acc, const Unit& un, int wr, int wc, int fr, int fq) const { EPI_LAUNDER
        const size_t o0 = (size_t)un.pm * 256 * 2048 + un.pn * 256 + lc_;
        EPI_ROWS_BEGIN
            const size_t ro = o0 + (size_t)rl * 2048; float rs = 0.f;
#pragma unroll
            for (int bj = 0; bj < 2; ++bj) { const f32x4 v0 = acc[ai][bj][m][0], v1 = acc[ai][bj][m][1];
                rs += v0[0] * v0[0] + v0[1] * v0[1] + v0[2] * v0[2] + v0[3] * v0[3] + v1[0] * v1[0] + v1[1] * v1[1] + v1[2] * v1[2] + v1[3] * v1[3];
                *(u32x4*)(dst + ro + bj * HALF) = pack8(v0, v1); }
            rs += __shfl_xor(rs, 16); rs += __shfl_xor(rs, 32);
            if (fq == 0) ssq[(size_t)(un.pm * 256 + rl) * 32 + un.pn * 4 + wc] = rs;
        EPI_ROWS_END
    }
};
struct EpiSwi {
    bf16_t* act; const float* rs;
    __device__ __forceinline__ void operator()(const Acc& acc, const Unit& un, int wr, int wc, int fr, int fq) const { EPI_LAUNDER
        bf16_t* d0 = act + (size_t)un.pm * 256 * DFF + un.pn * 128 + lc_;
        float r8[2][4];
#pragma unroll
        for (int ai = 0; ai < 2; ++ai)
#pragma unroll
            for (int m = 0; m < 4; ++m) r8[ai][m] = rs[un.pm * 256 + 128 * ai + 16 * m + lr_];
        EPI_ROWS_BEGIN
            const float r = r8[ai][m];
            const f32x4 g0 = acc[ai][0][m][0] * r, g1 = acc[ai][0][m][1] * r, u0 = acc[ai][1][m][0] * r, u1 = acc[ai][1][m][1] * r;
            *(u32x4*)(d0 + (size_t)rl * DFF) = pack8(g0 * sig4(g0) * u0, g1 * sig4(g1) * u1);
        EPI_ROWS_END
    }
};
struct EpiPle {
    float* y; const bf16_t* x2; const bf16_t* pe;
    __device__ __forceinline__ void operator()(const Acc& acc, const Unit& un, int wr, int wc, int fr, int fq) const { EPI_LAUNDER
        const size_t o0 = (size_t)un.pm * 256 * 2048 + un.pn * 256 + lc_;
#pragma unroll
        for (int ai = 0; ai < 2; ++ai) {
            u32x4 p4[4][2], x4[4][2];
#pragma unroll
            for (int m = 0; m < 4; ++m)
#pragma unroll
                for (int bj = 0; bj < 2; ++bj) { const size_t ro = o0 + (size_t)(128 * ai + 16 * m + lr_) * 2048 + bj * HALF; p4[m][bj] = *(const u32x4*)(pe + ro); x4[m][bj] = *(const u32x4*)(x2 + ro); }
            __builtin_amdgcn_sched_barrier(0);
#pragma unroll
            for (int m = 0; m < 4; ++m) { const size_t ro = o0 + (size_t)(128 * ai + 16 * m + lr_) * 2048;
#pragma unroll
                for (int bj = 0; bj < 2; ++bj) {
                    *(f32x4*)(y + ro + bj * HALF) = unlo(x4[m][bj]) + sig4(acc[ai][bj][m][0]) * unlo(p4[m][bj]);
                    *(f32x4*)(y + ro + bj * HALF + 4) = unhi(x4[m][bj]) + sig4(acc[ai][bj][m][1]) * unhi(p4[m][bj]); }
                __builtin_amdgcn_sched_barrier(0); }
        }
    }
};

__device__ __forceinline__ void transpose_item(const float* src, int ldw, bf16_t* dst, int ldd, LAS float* scr, int lane, const float* ks = nullptr) {
    f32x4 v[8];
#pragma unroll
    for (int i = 0; i < 8; ++i) v[i] = *(const f32x4*)(src + (size_t)(i * 8 + (lane >> 3)) * ldw + (lane & 7) * 4);
    if (ks) {
        float kv[8];
#pragma unroll
        for (int i = 0; i < 8; ++i) kv[i] = ks[i * 8 + (lane >> 3)];
#pragma unroll
        for (int i = 0; i < 8; ++i) v[i] = v[i] * kv[i]; }
#pragma unroll
    for (int i = 0; i < 8; ++i) { LAS float* s = scr + (i * 8 + (lane >> 3)) * 33 + (lane & 7) * 4; s[0] = v[i][0]; s[1] = v[i][1]; s[2] = v[i][2]; s[3] = v[i][3]; }
    LDS_WAIT();
    const int c = lane & 7;
#pragma unroll
    for (int j = 0; j < 4; ++j) { const int n = (lane >> 3) + 8 * j; const LAS float* s = scr + (8 * c) * 33 + n;
        u32x4 o; o.x = pk2(s[0 * 33], s[1 * 33]); o.y = pk2(s[2 * 33], s[3 * 33]); o.z = pk2(s[4 * 33], s[5 * 33]); o.w = pk2(s[6 * 33], s[7 * 33]);
        *(u32x4*)(dst + (size_t)n * ldd + 8 * c) = o; }
    LDS_WAIT();
}

__device__ __forceinline__ void weight_item(const Params& P, int it, LAS float* scr, int lane) {
    unsigned char* ws = P.ws;
    int r = it;
    if (r < 7168) { const int kb = r / 224, nb = r % 224; transpose_item(P.w_in + (size_t)kb * 64 * NIN + nb * 32, NIN, (bf16_t*)(ws + O_WIN) + (size_t)(nb * 32) * DM + kb * 64, DM, scr, lane); return; } r -= 7168;
    if (r < 4096) { const int kb = r / 128, nb = r % 128; transpose_item(P.w_in + (size_t)kb * 64 * NIN + 7176 + nb * 32, NIN, (bf16_t*)(ws + O_WIN) + (size_t)(7168 + nb * 32) * DM + kb * 64, DM, scr, lane); return; } r -= 4096;
    if (r < 5632) { const int kb = r / 176, nb = r % 176, n0 = nb * 32; transpose_item(P.w_gate + (size_t)kb * 64 * DFF + n0, DFF, (bf16_t*)(ws + O_WGU) + (size_t)((n0 >> 7) * 256 + (n0 & 127)) * DM + kb * 64, DM, scr, lane, P.g_pre_ffn + kb * 64); return; } r -= 5632;
    if (r < 5632) { const int kb = r / 176, nb = r % 176, n0 = nb * 32; transpose_item(P.w_up + (size_t)kb * 64 * DFF + n0, DFF, (bf16_t*)(ws + O_WGU) + (size_t)((n0 >> 7) * 256 + 128 + (n0 & 127)) * DM + kb * 64, DM, scr, lane, P.g_pre_ffn + kb * 64); return; } r -= 5632;
    if (r < 5632) { const int kb = r / 64, nb = r % 64; transpose_item(P.w_down + (size_t)kb * 64 * DM + nb * 32, DM, (bf16_t*)(ws + O_WDN) + (size_t)(nb * 32) * DFF + kb * 64, DFF, scr, lane); return; } r -= 5632;
    if (r < 1024) { const int kb = r / 64, nb = r % 64; transpose_item(P.w_pa + (size_t)kb * 64 * DM + nb * 32, DM, (bf16_t*)(ws + O_WPA) + (size_t)(nb * 32) * DP + kb * 64, DP, scr, lane); return; } r -= 1024;
    if (r < 2048) { const int kb = r / 64, nb = r % 64; transpose_item(P.w_pb + (size_t)kb * 64 * DM + nb * 32, DM, (bf16_t*)(ws + O_WPB) + (size_t)(nb * 32) * DM + kb * 64, DM, scr, lane); return; } r -= 2048;
    if (r < 2048) { const int kb = r / 64, nb = r % 64; transpose_item(P.w_out + (size_t)kb * 64 * DM + nb * 32, DM, (bf16_t*)(ws + O_WOUT) + (size_t)(nb * 32) * DM + kb * 64, DM, scr, lane); return; } r -= 2048;
    if (r < 2048) { const int kb = r / 64, nb = r % 64; transpose_item(P.w_ple_gate + (size_t)kb * 64 * DM + nb * 32, DM, (bf16_t*)(ws + O_WPG) + (size_t)(nb * 32) * DM + kb * 64, DM, scr, lane); return; } r -= 2048;
    if (r < 256) { const int kb = r / 64, nb = r % 64; transpose_item(P.w_ple + (size_t)kb * 64 * DM + nb * 32, DM, (bf16_t*)(ws + O_WPLE) + (size_t)(nb * 32) * PLE + kb * 64, PLE, scr, lane); return; } r -= 256;
    { const int g = r / 32, rr = r % 32, kb = rr / 8, nb = rr % 8;
      transpose_item(P.w_pool_grp + (size_t)g * 65536 + (size_t)kb * 64 * 256 + nb * 32, 256, (bf16_t*)(ws + O_WGRP) + (size_t)g * 65536 + (size_t)(nb * 32) * 256 + kb * 64, 256, scr, lane); }
}
constexpr int N_WITEMS = 7168 + 4096 + 5632 * 3 + 1024 + 2048 * 3 + 256 + 128;
constexpr int W_DN0 = 7168 + 4096 + 5632 * 2, W_PB0 = 7168 + 4096 + 5632 * 3 + 1024, W_LATE0 = W_PB0 + 2048, W_LATE1 = W_LATE0 + 2048 * 2;

template <int W>
__device__ __forceinline__ void pool_z_item(const Params& P, const bf16_t* ub, bf16_t* zb, int t, int ch0) {
    f32x4 sa = {0.f, 0.f, 0.f, 0.f}, sb = {0.f, 0.f, 0.f, 0.f}; float cnt; u32x4 cur;
    if (t < TP) { const int s = t & 2047, n = (s + 1 < W) ? s + 1 : W; cnt = (float)n;
        u32x4 r[W];
#pragma unroll
        for (int i = 0; i < W; ++i) r[i] = (i < n) ? *(const u32x4*)(ub + (size_t)(t - i) * 1024 + ch0) : (u32x4){0u, 0u, 0u, 0u};
        cur = r[0];
#pragma unroll
        for (int i = 0; i < W; ++i) { sa += unlo(r[i]); sb += unhi(r[i]); } }
    else { const int bs = (t - TP) >> 2, s = (t - TP) & 3; cnt = (float)W;
        cur = *(const u32x4*)(ub + (size_t)t * 1024 + ch0);
#pragma unroll
        for (int i = 0; i < W; ++i) { const int e = 15 + s - i;
            if (e >= 15) { const u32x4 r = *(const u32x4*)(ub + (size_t)(TP + bs * 4 + (e - 15)) * 1024 + ch0); sa += unlo(r); sb += unhi(r); }
            else { const float* sp = P.state_pool + ((size_t)bs * 15 + e) * 1024 + ch0; sa += *(const f32x4*)sp; sb += *(const f32x4*)(sp + 4); } } }
    const float ic = 1.f / cnt;
    *(u32x4*)(zb + (size_t)t * 1024 + ch0) = pack8(sa * ic - unlo(cur), sb * ic - unhi(cur));
}

__device__ __forceinline__ void sample_item(const Params& P, int item, LAS float* L) {
    const int tid = threadIdx.x, lane = tid & 63, wid = tid >> 6;
    const int b = item >> 2, h = item & 3, t0 = TP + b * 4;
    unsigned char* ws = P.ws;
    const bf16_t* qb = (const bf16_t*)(ws + O_Q); const bf16_t* kb = (const bf16_t*)(ws + O_K); const bf16_t* vb = (const bf16_t*)(ws + O_V);
    const float* igp = (const float*)(ws + O_IG); const float* lfp = (const float*)(ws + O_LF);
    LAS float* qs = L;
    LAS float* ks = L + 1024;
    LAS float* vs = L + 2048;
    LAS float* n0s = L + 4096;
    LAS float* red = L + 4352;
    LAS float* nred = L + 4608;
    for (int idx = tid; idx < 1024; idx += 512) { const int t = idx >> 8, d = idx & 255;
        qs[d * 4 + t] = bf1(qb[(size_t)(t0 + t) * 1024 + h * 256 + d]); ks[d * 4 + t] = bf1(kb[(size_t)(t0 + t) * 1024 + h * 256 + d]); }
    for (int idx = tid; idx < 2048; idx += 512) { const int t = idx >> 9, e = idx & 511; vs[idx] = bf1(vb[(size_t)(b * 4 + t) * 2048 + h * 512 + e]); }
    if (tid < 256) n0s[tid] = P.state_n[(size_t)(b * 4 + h) * 256 + tid];
    float bc[4], igv[4], mt[4], inter[4], Dt[4][4];
    const float m0 = P.state_m[b * 4 + h];
    { float cs = 0.f;
#pragma unroll
      for (int t = 0; t < 4; ++t) { cs += lfp[(t0 + t) * 4 + h]; bc[t] = cs; igv[t] = igp[(t0 + t) * 4 + h]; } }
#pragma unroll
    for (int t = 0; t < 4; ++t) { const float a = bc[t] + m0; float mm = a;
#pragma unroll
        for (int j = 0; j < 4; ++j) if (j <= t) mm = fmaxf(mm, bc[t] - bc[j] + igv[j]);
        mt[t] = mm; inter[t] = __expf(a - mm);
#pragma unroll
        for (int j = 0; j < 4; ++j) Dt[t][j] = (j <= t) ? __expf(bc[t] - bc[j] + igv[j] - mm) : 0.f; }
    const float m_new = mt[3], bL = bc[3], decay = __expf(bL + m0 - m_new);
    float wk[4];
#pragma unroll
    for (int j = 0; j < 4; ++j) wk[j] = __expf(bL - bc[j] + igv[j] - m_new);
    __syncthreads();
    for (int dt = wid; dt < 20; dt += 8) { float s = 0.f;
        if (dt < 16) { const int t = dt >> 2, j = dt & 3;
#pragma unroll
            for (int i = 0; i < 4; ++i) { const int d = lane + 64 * i; s += qs[d * 4 + t] * ks[d * 4 + j]; } }
        else { const int t = dt - 16;
#pragma unroll
            for (int i = 0; i < 4; ++i) { const int d = lane + 64 * i; s += qs[d * 4 + t] * n0s[d]; } }
        s = wave_sum(s); if (lane == 0) red[dt] = s; }
    __syncthreads();
    LAS float* sc = L + 4384;
    if (tid == 0) {
#pragma unroll
        for (int t = 0; t < 4; ++t) { float ds = inter[t] * red[16 + t];
#pragma unroll
            for (int j = 0; j < 4; ++j) { const float sv = red[t * 4 + j] * Dt[t][j]; sc[8 + t * 4 + j] = sv; ds += sv; }
            sc[t] = inter[t]; sc[4 + t] = fmaxf(fabsf(ds), __expf(-mt[t])); sc[24 + t] = wk[t]; }
    }
    __syncthreads();
    for (int idx = tid; idx < 1024; idx += 512) ks[idx] *= sc[24 + (idx & 3)];
    __syncthreads();
    const int cgp = tid & 127, dg = tid >> 7;
    f32x4 vv[4], nq[4];
#pragma unroll
    for (int j = 0; j < 4; ++j) { vv[j] = *(const LAS f32x4*)(vs + j * 512 + cgp * 4); nq[j] = (f32x4){0.f, 0.f, 0.f, 0.f}; }
    const f32x4* Cin = (const f32x4*)(P.state_C + (size_t)(b * 4 + h) * 256 * 512) + cgp;
    f32x4* Cout = (f32x4*)(P.out + OUT_CS + (size_t)(b * 4 + h) * 256 * 512) + cgp;
    for (int d0 = dg * 64; d0 < dg * 64 + 64; d0 += 16) {
        f32x4 cc[16];
#pragma unroll
        for (int i = 0; i < 16; ++i) cc[i] = __builtin_nontemporal_load(Cin + (size_t)(d0 + i) * 128);
#pragma unroll
        for (int i = 0; i < 16; ++i) { const f32x4 qd = *(const LAS f32x4*)(qs + (d0 + i) * 4), kd = *(const LAS f32x4*)(ks + (d0 + i) * 4);
            nq[0] += cc[i] * qd[0]; nq[1] += cc[i] * qd[1]; nq[2] += cc[i] * qd[2]; nq[3] += cc[i] * qd[3];
            f32x4 cn = cc[i] * decay + vv[0] * kd[0] + vv[1] * kd[1] + vv[2] * kd[2] + vv[3] * kd[3];
            __builtin_nontemporal_store(cn, Cout + (size_t)(d0 + i) * 128); }
    }
#pragma unroll
    for (int t = 0; t < 4; ++t) *(LAS f32x4*)(nred + (dg * 4 + t) * 512 + cgp * 4) = nq[t];
    __syncthreads();
    bf16_t* numb = (bf16_t*)(ws + O_NUM);
#pragma unroll
    for (int i = 0; i < 4; ++i) { const int idx = tid + 512 * i, t = idx >> 9, e = idx & 511;
        const float nqs = nred[(0 * 4 + t) * 512 + e] + nred[(1 * 4 + t) * 512 + e] + nred[(2 * 4 + t) * 512 + e] + nred[(3 * 4 + t) * 512 + e];
        const float it_ = sc[t], dd = sc[4 + t], s0 = sc[8 + t * 4], s1 = sc[9 + t * 4], s2 = sc[10 + t * 4], s3 = sc[11 + t * 4];
        const float val = it_ * nqs + s0 * vs[e] + s1 * vs[512 + e] + s2 * vs[1024 + e] + s3 * vs[1536 + e];
        const float hv = val / dd;
        numb[(size_t)(t0 + t) * 2048 + h * 512 + e] = (bf16_t)(pk2(hv, 0.f) & 0xffffu); }
    if (tid < 256) { const f32x4 kd = *(const LAS f32x4*)(ks + tid * 4);
        P.out[OUT_NS + (size_t)(b * 4 + h) * 256 + tid] = decay * n0s[tid] + kd[0] + kd[1] + kd[2] + kd[3]; }
    if (tid == 0) P.out[OUT_MS + b * 4 + h] = m_new;
    __syncthreads();
}


#define XB_TMO      128
#define XB_XCNT(j)  (256  + 64 * (j))
#define XB_XSUB(j)  (1280 + 64 * (j))
#define XB_XGEN(j)  (2304 + 64 * (j))
#define XB_TOP      3328
#define XB_TOPGEN   3392
#define XCD_BAR_WORDS 3456
#define XB_SPIN_CAP (1u << 22)
__device__ __forceinline__ unsigned xb_ld(unsigned* p)              { return __hip_atomic_load(p, __ATOMIC_RELAXED, __HIP_MEMORY_SCOPE_AGENT); }
__device__ __forceinline__ unsigned xb_add(unsigned* p, unsigned v) { return __hip_atomic_fetch_add(p, v, __ATOMIC_RELAXED, __HIP_MEMORY_SCOPE_AGENT); }
__device__ __forceinline__ unsigned xb_xcc_id() { return (unsigned)__builtin_amdgcn_s_getreg((3 << 11) | 20) & 0xFu; }
#define XB_SPIN(cond, bar) do { unsigned _sp = 0; while (cond) { __builtin_amdgcn_s_sleep(1); \
    if ((++_sp & 255u) == 0u) { if (xb_ld(&(bar)[XB_TMO])) break; if (_sp > XB_SPIN_CAP) { atomicAdd(&(bar)[XB_TMO], 1u); break; } } } } while (0)
struct XcdBarrier { unsigned* bar; unsigned x; volatile LAS unsigned* st; };
__device__ __forceinline__ XcdBarrier xcd_barrier_post(unsigned* bar, volatile LAS unsigned* st) {
    XcdBarrier b; b.bar = bar; b.x = xb_xcc_id(); b.st = st;
    if (threadIdx.x == 0) (void)xb_add(&bar[XB_XCNT(b.x)], 1u);
    return b;
}
__device__ __forceinline__ void xcd_barrier_complete(unsigned* bar, unsigned x, unsigned& nloc, unsigned& nx) {
    const unsigned G = gridDim.x * gridDim.y * gridDim.z;
    unsigned sum, cnt, mine, sp = 0u;
    for (;;) {
        sum = 0u; cnt = 0u; mine = 0u;
#pragma unroll
        for (unsigned j = 0; j < 16; ++j) { const unsigned c = xb_ld(&bar[XB_XCNT(j)]); sum += c; cnt += (c > 0u) ? 1u : 0u; mine = (j == x) ? c : mine; }
        if (sum == G) break;
        __builtin_amdgcn_s_sleep(1);
        if ((++sp & 255u) == 0u) { if (xb_ld(&bar[XB_TMO])) break; if (sp > XB_SPIN_CAP) { atomicAdd(&bar[XB_TMO], 1u); break; } }
    }
    nloc = mine > 0u ? mine : 1u; nx = cnt > 0u ? cnt : 1u;
}
__device__ __forceinline__ void xcd_barrier(const XcdBarrier& b) {
    asm volatile("s_waitcnt vmcnt(0)" ::: "memory");
    __syncthreads();
    if (threadIdx.x == 0) {
        unsigned* bar = b.bar;
        __builtin_amdgcn_s_waitcnt(0);
        unsigned nloc = b.st[0], nx = b.st[1];
        if (nloc == 0u) { xcd_barrier_complete(bar, b.x, nloc, nx); b.st[0] = nloc; b.st[1] = nx; }
        const unsigned old = xb_add(&bar[XB_XSUB(b.x)], 1u);
        const unsigned gen = old / nloc;
        if (old + 1u == (gen + 1u) * nloc) {
            __builtin_amdgcn_fence(__ATOMIC_RELEASE, "agent");
            asm volatile("s_waitcnt vmcnt(0)" ::: "memory");
            const unsigned og = xb_add(&bar[XB_TOP], 1u);
            const unsigned tg = og / nx;
            if (og + 1u == (tg + 1u) * nx) xb_add(&bar[XB_TOPGEN], 1u);
            else XB_SPIN(xb_ld(&bar[XB_TOPGEN]) == tg, bar);
            __builtin_amdgcn_fence(__ATOMIC_ACQUIRE, "agent");
            xb_add(&bar[XB_XGEN(b.x)], 1u);
            asm volatile("s_waitcnt vmcnt(0)" ::: "memory");
        } else {
            XB_SPIN(xb_ld(&bar[XB_XGEN(b.x)]) == gen, bar);
            __builtin_amdgcn_fence(__ATOMIC_ACQUIRE, "agent");
            asm volatile("s_waitcnt vmcnt(0)" ::: "memory");
        }
    }
    __syncthreads();
}

#define WinT ((bf16_t*)(ws + O_WIN))
#define WguT ((bf16_t*)(ws + O_WGU))
#define WdnT ((bf16_t*)(ws + O_WDN))
#define WpaT ((bf16_t*)(ws + O_WPA))
#define WpbT ((bf16_t*)(ws + O_WPB))
#define WoutT ((bf16_t*)(ws + O_WOUT))
#define WpgT ((bf16_t*)(ws + O_WPG))
#define WpleT ((bf16_t*)(ws + O_WPLE))
#define WgrpT ((bf16_t*)(ws + O_WGRP))
#define h1 ((bf16_t*)(ws + O_H1))
#define merged h1
#define so ((bf16_t*)(ws + O_SO))
#define x2b so
#define ga ((bf16_t*)(ws + O_GA))
#define gb ((bf16_t*)(ws + O_GB))
#define numb ((bf16_t*)(ws + O_NUM))
#define tout numb
#define bm ((bf16_t*)(ws + O_BM))
#define h2 bm
#define T1 ((bf16_t*)(ws + O_T1))
#define fout T1
#define pe ((bf16_t*)(ws + O_PE))
#define vs_ ((bf16_t*)(ws + O_V))
#define ub ((bf16_t*)(ws + O_U))
#define qb ((bf16_t*)(ws + O_Q))
#define kb ((bf16_t*)(ws + O_K))
#define zb ((bf16_t*)(ws + O_Z))
#define ab ((bf16_t*)(ws + O_A))
#define vT ((bf16_t*)(ws + O_VT))
#define kwT ((bf16_t*)(ws + O_KWT))
#define pbf ((bf16_t*)(ws + O_PBF))
#define Sall ((bf16_t*)(ws + O_S))
#define act Sall
#define x1b ((bf16_t*)(ws + O_X1))
#define rs2b ((float*)(ws + O_SU))
#define igp ((float*)(ws + O_IG))
#define lfp ((float*)(ws + O_LF))
#define su ((float*)(ws + O_SU))
#define sw ((float*)(ws + O_SW))
#define sem ((float*)(ws + O_SEM))
#define swkf ((float*)(ws + O_SWKF))
#define denp ((float*)(ws + O_DENP))
#define ssq ((float*)(ws + O_SSQ))
#define part ((float*)(ws + O_PART))
#define flags ((unsigned*)(ws + O_FLAG))
#define barw ((unsigned*)(ws + O_BAR))
__global__ void __launch_bounds__(512, 2) mega(Params P) {
    extern __shared__ __attribute__((aligned(16))) unsigned char lds_raw[];
    LAS unsigned char* lds = (LAS unsigned char*)lds_raw;
    cg::grid_group grid = cg::this_grid();
    const int tid = threadIdx.x, lane = tid & 63, wid = __builtin_amdgcn_readfirstlane(tid >> 6), G = gridDim.x, bid = blockIdx.x;
    const int gw = bid * 8 + wid, NGW = G * 8;
    unsigned char* ws = P.ws;

    if constexpr ((PHM >> 0) & 1)
    {
        LAS float* WgT = (LAS float*)lds;
        if (bid == 0) { for (int i = tid; i < 5 * 256 + 1; i += 512) flags[i * 16] = 0u; for (int i = tid; i < XCD_BAR_WORDS; i += 512) barw[i] = 0u; }
        if (tid < 4) ((volatile LAS unsigned*)(lds + LDS_BYTES - 16))[tid] = 0u;
        for (int k = tid; k < 2048; k += 512) { const f32x4 a = *(const f32x4*)(P.w_in + (size_t)k * NIN + 7168), b2 = *(const f32x4*)(P.w_in + (size_t)k * NIN + 7172);
            WgT[0 * 2048 + k] = a[0]; WgT[1 * 2048 + k] = a[1]; WgT[2 * 2048 + k] = a[2]; WgT[3 * 2048 + k] = a[3];
            WgT[4 * 2048 + k] = b2[0]; WgT[5 * 2048 + k] = b2[1]; WgT[6 * 2048 + k] = b2[2]; WgT[7 * 2048 + k] = b2[3]; }
        __syncthreads();
        for (int t = gw; t < T; t += NGW) {
            const float* xr = (t < TP) ? P.x_prompt + (size_t)t * DM : P.x_sample + (size_t)(t - TP) * DM;
            f32x4 v[8]; float ss = 0.f;
#pragma unroll
            for (int j = 0; j < 8; ++j) { v[j] = ((const f32x4*)xr)[lane + 64 * j]; ss += v[j][0] * v[j][0] + v[j][1] * v[j][1] + v[j][2] * v[j][2] + v[j][3] * v[j][3]; }
            ss = wave_sum(ss); const float rstd = rsqrtf(ss * (1.f / DM) + EPS);
            u32x2* hr = (u32x2*)(h1 + (size_t)t * DM);
#pragma unroll
            for (int j = 0; j < 8; ++j) { const f32x4 g = ((const f32x4*)P.g_pre_mix)[lane + 64 * j]; v[j] = v[j] * rstd * g;
                u32x2 o; o.x = pk2(v[j][0], v[j][1]); o.y = pk2(v[j][2], v[j][3]); hr[lane + 64 * j] = o; }
            float gacc[8];
#pragma unroll
            for (int c = 0; c < 8; ++c) { float s = 0.f;
#pragma unroll
                for (int j = 0; j < 8; ++j) { const f32x4 w = *(const LAS f32x4*)(WgT + c * 2048 + 256 * j + 4 * lane); s += v[j][0] * w[0] + v[j][1] * w[1] + v[j][2] * w[2] + v[j][3] * w[3]; }
                gacc[c] = wave_sum(s); }
            if (lane == 0) {
#pragma unroll
                for (int hh = 0; hh < 4; ++hh) { igp[t * 4 + hh] = gacc[hh] + P.b_i[hh]; const float f = gacc[4 + hh] + P.b_f[hh];
                    lfp[t * 4 + hh] = fminf(f, 0.f) - log1pf(__expf(-fabsf(f))); } }
        }
        __syncthreads();
        LAS float* scr = (LAS float*)(lds + 65536) + wid * (64 * 33);
        for (int it = gw; it < 11264 + 1024 + (N_WITEMS - W_LATE1); it += NGW) {
            const int r = it < 11264 ? it : (it < 11264 + 1024 ? it - 11264 + (W_PB0 - 1024) : it - (11264 + 1024) + W_LATE1);
            weight_item(P, r, scr, lane); }
        for (int idx = bid * 512 + tid; idx < T * 32; idx += G * 512) { const int t = idx >> 5, c8 = (idx & 31) * 8;
            const float* pr = (t < TP) ? P.p_prompt + (size_t)t * PLE : P.p_sample + (size_t)(t - TP) * PLE;
            const f32x4 a = *(const f32x4*)(pr + c8), b2 = *(const f32x4*)(pr + c8 + 4);
            *(u32x4*)(pbf + (size_t)t * PLE + c8) = pack8(a, b2); }
    }
    grid.sync();
    const XcdBarrier xb = xcd_barrier_post(barw, (volatile LAS unsigned*)(lds + LDS_BYTES - 16));

    if constexpr ((PHM >> 1) & 1)
    {
        SchedP1 S1{G, bid, (const char*)h1, (const char*)WinT};
        EpiP1 E1{ub, qb, kb, vs_, so, ga, gb, vT};
        gemm_phase(lds, 2048, 2048, S1, E1);
        {
            const int rem = 1496 % G, nsl = rem ? G - rem : G, sl = rem ? bid - rem : bid;
            if (sl >= 0) { LAS float* scr = (LAS float*)lds + wid * (64 * 33);
                for (int it = W_LATE0 + sl * 8 + wid; it < W_LATE1; it += nsl * 8) weight_item(P, it, scr, lane); }
        }
        const int bh = bid - (G - 16);
        if (bh >= 0 && bh < 16 && wid == 0) {
            const int b = bh >> 2, h = bh & 3; float Bc = 0.f, Mc = 0.f;
            float lv[32], wv[32];
#pragma unroll
            for (int c = 0; c < 32; ++c) { const int t = b * 2048 + c * 64 + lane; lv[c] = lfp[t * 4 + h]; wv[c] = igp[t * 4 + h]; }
#pragma unroll
            for (int c = 0; c < 32; ++c) { const int s = c * 64 + lane;
                float cs = lv[c];
#pragma unroll
                for (int o = 1; o < 64; o <<= 1) { const float y = __shfl_up(cs, o); if (lane >= o) cs += y; }
                const float Bt = Bc + cs, w = wv[c] - Bt; float mx = w;
#pragma unroll
                for (int o = 1; o < 64; o <<= 1) { const float y = __shfl_up(mx, o); if (lane >= o) mx = fmaxf(mx, y); }
                mx = fmaxf(mx, Mc); wv[c] = w;
                su[bh * 2048 + s] = -mx * LOG2E; sw[bh * 2048 + s] = w * LOG2E; sem[bh * 2048 + s] = __expf(-(Bt + mx));
                Bc = __shfl(Bt, 63); Mc = __shfl(mx, 63); }
#pragma unroll
            for (int c = 0; c < 32; ++c) { const int s = c * 64 + lane; swkf[bh * 2048 + s] = __builtin_amdgcn_exp2f((wv[c] - Mc) * LOG2E); }
            if (lane == 0) P.out[OUT_MP + bh] = Bc + Mc;
        }
    }
    xcd_barrier(xb);

    if constexpr ((PHM >> 2) & 1)
    {
        SchedQK S1{G, bid, (const char*)qb, (const char*)kb};
        EpiS E1{Sall, su, sw, denp};
        if constexpr (P2M & 1) gemm_phase(lds, 1024, 1024, S1, E1);
        if constexpr (P2M & 2)
        for (int idx = bid * 512 + tid; idx < T * 128; idx += G * 512) {
            const int t = idx >> 7, ch0 = (idx & 127) * 8, g = ch0 >> 8;
            if (g == 0) pool_z_item<2>(P, ub, zb, t, ch0); else if (g == 1) pool_z_item<4>(P, ub, zb, t, ch0);
            else if (g == 2) pool_z_item<8>(P, ub, zb, t, ch0); else pool_z_item<16>(P, ub, zb, t, ch0);
        }
        for (int idx = bid * 512 + tid; idx < 4 * 15 * 128; idx += G * 512) { const int c8 = (idx & 127) * 8, r = (idx >> 7) % 15, b = idx / (15 * 128);
            const u32x4 v = *(const u32x4*)(ub + (size_t)(b * 2048 + 2033 + r) * 1024 + c8); float* o = P.out + OUT_POOLP + ((size_t)b * 15 + r) * 1024 + c8;
            *(f32x4*)o = unlo(v); *(f32x4*)(o + 4) = unhi(v); }
        for (int idx = bid * 512 + tid; idx < 128 * 15 * 128; idx += G * 512) { const int c8 = (idx & 127) * 8, r = (idx >> 7) % 15, b = idx / (15 * 128);
            float* o = P.out + OUT_POOLS + ((size_t)b * 15 + r) * 1024 + c8;
            if (r < 11) { const float* sp = P.state_pool + ((size_t)b * 15 + r + 4) * 1024 + c8; *(f32x4*)o = *(const f32x4*)sp; *(f32x4*)(o + 4) = *(const f32x4*)(sp + 4); }
            else { const u32x4 v = *(const u32x4*)(ub + (size_t)(TP + b * 4 + (r - 11)) * 1024 + c8); *(f32x4*)o = unlo(v); *(f32x4*)(o + 4) = unhi(v); } }
        if constexpr (P2M & 4) {
            LAS float* scr = (LAS float*)lds + wid * (64 * 33);
            for (int it = gw; it < 128 * 32; it += NGW) { const int tb = it >> 5, db = it & 31, tok0 = tb * 64, d0 = db * 32, b = tok0 >> 11, h = d0 >> 8, bh = b * 4 + h;
#pragma unroll
                for (int i = 0; i < 4; ++i) { const int r = i * 16 + (lane >> 2); const u32x4 raw = *(const u32x4*)(kb + (size_t)(tok0 + r) * 1024 + d0 + (lane & 3) * 8);
                    const float wv = swkf[bh * 2048 + (tok0 & 2047) + r]; LAS float* s = scr + r * 33 + (lane & 3) * 8; const f32x4 a = unlo(raw) * wv, b2 = unhi(raw) * wv;
                    s[0] = a[0]; s[1] = a[1]; s[2] = a[2]; s[3] = a[3]; s[4] = b2[0]; s[5] = b2[1]; s[6] = b2[2]; s[7] = b2[3]; }
                LDS_WAIT();
                const int c = lane & 7;
#pragma unroll
                for (int j = 0; j < 4; ++j) { const int d = (lane >> 3) + 8 * j; const LAS float* s = scr + (8 * c) * 33 + d;
                    u32x4 o; o.x = pk2(s[0 * 33], s[1 * 33]); o.y = pk2(s[2 * 33], s[3 * 33]); o.z = pk2(s[4 * 33], s[5 * 33]); o.w = pk2(s[6 * 33], s[7 * 33]);
                    *(u32x4*)(kwT + (size_t)(d0 + d) * TP + tok0 + 8 * c) = o; }
                LDS_WAIT();
            }
            {
                const int rem = 576 % G, nsl = rem ? G - rem : G, sl = rem ? bid - rem : bid;
                if (sl >= 0) for (int it = 16896 + sl * 8 + wid; it < 16896 + 5632; it += nsl * 8) weight_item(P, it, scr, lane);
            }
        }
        __syncthreads();
    }
    xcd_barrier(xb);

    if constexpr ((PHM >> 3) & 1)
    {
        SchedSV S1{G, bid, (const char*)Sall, (const char*)vT, (const char*)kwT};
        EpiSV E1{numb, P.out + OUT_CP};
        gemm_phase(lds, 8192, 8192, S1, E1);
        SchedPool S2{G, bid, (const char*)zb, (const char*)WgrpT};
        EpiPool E2{ab, P.s_pool};
        gemm_phase(lds, 1024, 256, S2, E2);
        __syncthreads();
        {
            volatile LAS int* qslot = (volatile LAS int*)(lds + LDS_BYTES - 32);
            for (;;) {
                if (tid == 0) *qslot = (int)__hip_atomic_fetch_add(flags + 5 * 4096, 1u, __ATOMIC_RELAXED, __HIP_MEMORY_SCOPE_AGENT);
                __syncthreads();
                const int item = *qslot;
                __syncthreads();
                if (item >= 512) break;
                sample_item(P, item, (LAS float*)lds);
            }
        }
        for (int r = gw; r < 16 * 256; r += NGW) { const int bh = r >> 8, d = r & 255, b = bh >> 2, h = bh & 3; float s = 0.f;
            const bf16_t* kr = kwT + (size_t)(h * 256 + d) * TP + b * 2048;
#pragma unroll
            for (int j = 0; j < 4; ++j) { const u32x4 w = *(const u32x4*)(kr + (lane + 64 * j) * 8); const f32x4 a = unlo(w), b2 = unhi(w); s += a[0] + a[1] + a[2] + a[3] + b2[0] + b2[1] + b2[2] + b2[3]; }
            s = wave_sum(s); if (lane == 0) P.out[OUT_NP + r] = s; }
    }
    xcd_barrier(xb);

    if constexpr ((PHM >> 4) & 1)
    {
        for (int t = gw; t < T; t += NGW) {
            u32x4 raw[4], sr[4]; float dsum[4], emv[4];
#pragma unroll
            for (int h = 0; h < 4; ++h) { raw[h] = *(const u32x4*)(numb + (size_t)t * 2048 + h * 512 + lane * 8); sr[h] = *(const u32x4*)(so + (size_t)t * 2048 + h * 512 + lane * 8); dsum[h] = 0.f; emv[h] = 1.f; }
            if (t < TP) { const int b = t >> 11, s = t & 2047, cnt = 4 * ((s >> 8) + 1);
#pragma unroll
                for (int h = 0; h < 4; ++h) { const int bh = b * 4 + h; dsum[h] = (lane < cnt) ? denp[(size_t)(bh * 2048 + s) * 32 + lane] : 0.f; emv[h] = sem[bh * 2048 + s]; }
#pragma unroll
                for (int o = 1; o < 64; o <<= 1) {
#pragma unroll
                    for (int h = 0; h < 4; ++h) dsum[h] += __shfl_xor(dsum[h], o); }
            }
            f32x4 a[4], b2[4]; float ss[4];
#pragma unroll
            for (int h = 0; h < 4; ++h) { a[h] = unlo(raw[h]); b2[h] = unhi(raw[h]);
                if (t < TP) { const float dd = 1.f / fmaxf(fabsf(dsum[h]), emv[h]); a[h] = a[h] * dd; b2[h] = b2[h] * dd; }
                ss[h] = a[h][0] * a[h][0] + a[h][1] * a[h][1] + a[h][2] * a[h][2] + a[h][3] * a[h][3] + b2[h][0] * b2[h][0] + b2[h][1] * b2[h][1] + b2[h][2] * b2[h][2] + b2[h][3] * b2[h][3]; }
#pragma unroll
            for (int o = 1; o < 64; o <<= 1) {
#pragma unroll
                for (int h = 0; h < 4; ++h) ss[h] += __shfl_xor(ss[h], o); }
#pragma unroll
            for (int h = 0; h < 4; ++h) { const float rstd = rsqrtf(ss[h] * (1.f / 512.f) + EPS);
                const f32x4 g0 = *(const f32x4*)(P.g_head + h * 512 + lane * 8), g1 = *(const f32x4*)(P.g_head + h * 512 + lane * 8 + 4);
                *(u32x4*)(bm + (size_t)t * 2048 + h * 512 + lane * 8) = pack8(a[h] * rstd * g0 * sig4(unlo(sr[h])), b2[h] * rstd * g1 * sig4(unhi(sr[h]))); }
        }
        __syncthreads();
        SchedU S1; S1.init(G, bid, ab, 1024, WpaT, 1024, 34, 8, 1024);
        EpiPA E1{T1, ga};
        gemm_phase(lds, 1024, 1024, S1, E1);
        SchedPe S2{G, bid, (const char*)pbf, (const char*)WpleT};
        EpiBf E2{pe, 2048};
        gemm_phase(lds, PLE, PLE, S2, E2);
        {
            const int skip = (272 - G > 0 && 272 - G < G) ? 272 - G : 0;
            if (bid >= skip) { LAS float* scr = (LAS float*)lds + wid * (64 * 33);
                for (int it = W_PB0 + (bid - skip) * 8 + wid; it < W_PB0 + 2048; it += (G - skip) * 8) weight_item(P, it, scr, lane);
                for (int it = 11264 + (bid - skip) * 8 + wid; it < 11264 + 5632; it += (G - skip) * 8) weight_item(P, it, scr, lane); }
        }
    }
    xcd_barrier(xb);

    if constexpr ((PHM >> 5) & 1)
    {
        SchedK S1; S1.init(G, bid, bm, 2048, WpbT, 2048, 34, 8, 2048);
        EpiPB E1{merged, T1, gb};
        gemm_phase(lds, 2048, 2048, S1, E1, part, flags + 1 * 4096, 8u * (REPI + 1));
    }
    xcd_barrier(xb);

    if constexpr ((PHM >> 6) & 1)
    {
        SchedK S1; S1.init(G, bid, merged, 2048, WoutT, 2048, 34, 8, 2048);
        EpiSq E1{tout, ssq};
        gemm_phase(lds, 2048, 2048, S1, E1, part, flags + 2 * 4096, 8u * (REPI + 1));
    }
    xcd_barrier(xb);

    if constexpr ((PHM >> 7) & 1)
    {
        for (int t = gw; t < T; t += NGW) {
            const float* xr = (t < TP) ? P.x_prompt + (size_t)t * DM : P.x_sample + (size_t)(t - TP) * DM;
            float q = (lane < 32) ? ssq[(size_t)t * 32 + lane] : 0.f; q = wave_sum(q); const float rs1 = rsqrtf(q * (1.f / DM) + EPS);
            f32x4 xa[4], xb[4]; float ss = 0.f;
#pragma unroll
            for (int j = 0; j < 4; ++j) { const int c = lane * 8 + 512 * j; const u32x4 raw = *(const u32x4*)(tout + (size_t)t * DM + c);
                const f32x4 g0 = *(const f32x4*)(P.g_post_mix + c), g1 = *(const f32x4*)(P.g_post_mix + c + 4);
                xa[j] = *(const f32x4*)(xr + c) + unlo(raw) * rs1 * g0; xb[j] = *(const f32x4*)(xr + c + 4) + unhi(raw) * rs1 * g1;
                *(u32x4*)(x1b + (size_t)t * DM + c) = pack8(xa[j], xb[j]);
                ss += xa[j][0] * xa[j][0] + xa[j][1] * xa[j][1] + xa[j][2] * xa[j][2] + xa[j][3] * xa[j][3] + xb[j][0] * xb[j][0] + xb[j][1] * xb[j][1] + xb[j][2] * xb[j][2] + xb[j][3] * xb[j][3]; }
            ss = wave_sum(ss); if (lane == 0) rs2b[t] = rsqrtf(ss * (1.f / DM) + EPS);
        }
    }
    xcd_barrier(xb);

    if constexpr ((PHM >> 8) & 1)
    {
        SchedU S1; S1.init(G, bid, x1b, 2048, WguT, 2048, 34, 44, 2048);
        EpiSwi E1{act, rs2b};
        gemm_phase(lds, 2048, 2048, S1, E1);
        {
            const int rem = 1496 % G, nsl = rem ? G - rem : G, sl = rem ? bid - rem : bid;
            if (sl >= 0) { LAS float* scr = (LAS float*)lds + wid * (64 * 33);
                for (int it = W_DN0 + sl * 8 + wid; it < W_DN0 + 5632; it += nsl * 8) weight_item(P, it, scr, lane); }
        }
    }
    xcd_barrier(xb);

    if constexpr ((PHM >> 9) & 1)
    {
        SchedK S1; S1.init(G, bid, act, DFF, WdnT, DFF, 34, 8, DFF);
        EpiSq E1{fout, ssq};
        gemm_phase(lds, DFF, DFF, S1, E1, part, flags + 3 * 4096, 8u * (REPI + 1));
    }
    xcd_barrier(xb);

    if constexpr ((PHM >> 10) & 1)
    {
        for (int t = gw; t < T; t += NGW) {
            float q = (lane < 32) ? ssq[(size_t)t * 32 + lane] : 0.f; q = wave_sum(q); const float rs1 = rsqrtf(q * (1.f / DM) + EPS);
#pragma unroll
            for (int j = 0; j < 4; ++j) { const int c = lane * 8 + 512 * j; const u32x4 raw = *(const u32x4*)(fout + (size_t)t * DM + c);
                const f32x4 g0 = *(const f32x4*)(P.g_post_ffn + c), g1 = *(const f32x4*)(P.g_post_ffn + c + 4);
                const u32x4 xr1 = *(const u32x4*)(x1b + (size_t)t * DM + c);
                const f32x4 a = unlo(xr1) + unlo(raw) * rs1 * g0, b2 = unhi(xr1) + unhi(raw) * rs1 * g1;
                *(u32x4*)(x2b + (size_t)t * DM + c) = pack8(a, b2); }
        }
    }
    xcd_barrier(xb);

    if constexpr ((PHM >> 11) & 1)
    {
        SchedK S1; S1.init(G, bid, x2b, 2048, WpgT, 2048, 34, 8, 2048);
        EpiPle E1{P.out, x2b, pe};
        gemm_phase(lds, 2048, 2048, S1, E1, part, flags + 4 * 4096, 8u * (REPI + 1));
    }
}

#undef WinT
#undef WguT
#undef WdnT
#undef WpaT
#undef WpbT
#undef WoutT
#undef WpgT
#undef WpleT
#undef WgrpT
#undef h1
#undef merged
#undef so
#undef x2b
#undef ga
#undef gb
#undef numb
#undef tout
#undef bm
#undef h2
#undef T1
#undef fout
#undef pe
#undef vs_
#undef ub
#undef qb
#undef kb
#undef zb
#undef ab
#undef vT
#undef kwT
#undef pbf
#undef Sall
#undef act
#undef x1b
#undef rs2b
#undef igp
#undef lfp
#undef su
#undef sw
#undef sem
#undef swkf
#undef denp
#undef ssq
#undef part
#undef flags
#undef barw

extern "C" void kernel_launch(void* const* d_in, const int* in_sizes, int n_in, void* d_out, int out_size, void* d_ws, size_t ws_size, hipStream_t stream) {
    static int grid = 0;
    if (grid == 0) {
        if (n_in != 26 || ws_size < O_END) { fprintf(stderr, "kernel_launch: unexpected n_in %d or workspace %zu < %zu\n", n_in, ws_size, (size_t)O_END); grid = -1; return; }
        int dev = 0, cus = 0, per_cu = 0;
        (void)hipGetDevice(&dev);
        (void)hipDeviceGetAttribute(&cus, hipDeviceAttributeMultiprocessorCount, dev);
        if (hipFuncSetAttribute((const void*)mega, hipFuncAttributeMaxDynamicSharedMemorySize, LDS_BYTES) != hipSuccess) { fprintf(stderr, "kernel_launch: hipFuncSetAttribute failed\n"); grid = -1; return; }
        if (hipOccupancyMaxActiveBlocksPerMultiprocessor(&per_cu, (const void*)mega, 512, LDS_BYTES) != hipSuccess || per_cu < 1) { fprintf(stderr, "kernel_launch: occupancy query gave %d\n", per_cu); per_cu = 1; }
        (void)hipGetLastError();
        grid = cus * 1;
        if (grid > 256) grid = 256;
    }
    if (grid < 0) return;
    Params p{};
    const float** pp = (const float**)&p;
    for (int i = 0; i < 26; ++i) pp[i] = (const float*)d_in[i];
    p.out = (float*)d_out; p.ws = (unsigned char*)d_ws;
    void* args[] = {&p};
    hipError_t e = hipLaunchCooperativeKernel((const void*)mega, dim3(grid), dim3(512), args, LDS_BYTES, stream);
    if (e != hipSuccess) fprintf(stderr, "cooperative launch failed: %s (grid %d)\n", hipGetErrorString(e), grid);
}
```

```cpp
#include <hip/hip_runtime.h>
#include <hip/hip_cooperative_groups.h>
#include <cstdio>
namespace cg = cooperative_groups;

#define LAS __attribute__((address_space(3)))
typedef unsigned short bf16_t;
typedef short bf16x8 __attribute__((ext_vector_type(8)));
typedef float f32x4 __attribute__((ext_vector_type(4)));
typedef unsigned u32x4 __attribute__((ext_vector_type(4)));
typedef unsigned u32x2 __attribute__((ext_vector_type(2)));

constexpr int T = 8704, TP = 8192, TS = 512, DM = 2048, NIN = 11272, NP = 11264, DP = 1024, HQK = 1024, HV = 2048, DFF = 5632, PLE = 256;
constexpr float EPS = 1e-6f, LOG2E = 1.4426950408889634f;
constexpr size_t OUT_YS = (size_t)TP * DM, OUT_POOLP = OUT_YS + (size_t)TS * DM, OUT_CP = OUT_POOLP + 4 * 15 * 1024,
                 OUT_NP = OUT_CP + (size_t)16 * 256 * 512, OUT_MP = OUT_NP + 16 * 256, OUT_POOLS = OUT_MP + 16,
                 OUT_CS = OUT_POOLS + (size_t)128 * 15 * 1024, OUT_NS = OUT_CS + (size_t)512 * 256 * 512, OUT_MS = OUT_NS + 512 * 256;
constexpr size_t O_WIN = 0;
constexpr size_t O_WGU = O_WIN + (size_t)NP * DM * 2;
constexpr size_t O_WDN = O_WGU + (size_t)NP * DM * 2;
constexpr size_t O_WPA = O_WDN + (size_t)DM * DFF * 2;
constexpr size_t O_WPB = O_WPA + (size_t)DM * DP * 2;
constexpr size_t O_WOUT = O_WPB + (size_t)DM * DM * 2;
constexpr size_t O_WPG = O_WOUT + (size_t)DM * DM * 2;
constexpr size_t O_WPLE = O_WPG + (size_t)DM * DM * 2;
constexpr size_t O_WGRP = O_WPLE + (size_t)DM * PLE * 2;
constexpr size_t O_H1 = O_WGRP + (size_t)DP * 256 * 2;
constexpr size_t O_SO = O_H1 + (size_t)T * DM * 2;
constexpr size_t O_GA = O_SO + (size_t)T * DM * 2;
constexpr size_t O_GB = O_GA + (size_t)T * DM * 2;
constexpr size_t O_NUM = O_GB + (size_t)T * DM * 2;
constexpr size_t O_BM = O_NUM + (size_t)T * DM * 2;
constexpr size_t O_T1 = O_BM + (size_t)T * DM * 2;
constexpr size_t O_PE = O_T1 + (size_t)T * DM * 2;
constexpr size_t O_V = O_PE + (size_t)T * DM * 2;
constexpr size_t O_U = O_V + (size_t)TS * HV * 2;
constexpr size_t O_Q = O_U + (size_t)T * 1024 * 2;
constexpr size_t O_K = O_Q + (size_t)T * 1024 * 2;
constexpr size_t O_Z = O_K + (size_t)T * 1024 * 2;
constexpr size_t O_A = O_Z + (size_t)T * 1024 * 2;
constexpr size_t O_VT = O_A + (size_t)T * 1024 * 2;
constexpr size_t O_KWT = O_VT + (size_t)HV * TP * 2;
constexpr size_t O_PBF = O_KWT + (size_t)HQK * TP * 2;
constexpr size_t O_S = O_PBF + (size_t)T * PLE * 2;
constexpr size_t O_X1 = O_S + (size_t)TP * 8192 * 2;
constexpr size_t O_IG = O_X1 + (size_t)T * DM * 4;
constexpr size_t O_LF = O_IG + (size_t)T * 4 * 4;
constexpr size_t O_SU = O_LF + (size_t)T * 4 * 4;
constexpr size_t O_SW = O_SU + 16 * 2048 * 4;
constexpr size_t O_SEM = O_SW + 16 * 2048 * 4;
constexpr size_t O_SWKF = O_SEM + 16 * 2048 * 4;
constexpr size_t O_DENP = O_SWKF + 16 * 2048 * 4;
constexpr size_t O_SSQ = O_DENP + (size_t)16 * 2048 * 32 * 4;
constexpr size_t O_FLAG = O_SSQ + (size_t)T * 32 * 4;
constexpr size_t O_BAR = O_FLAG + 1024 * 64 * 4;
constexpr size_t O_PART = O_BAR + 16384;
constexpr size_t O_END = O_PART + (size_t)256 * 32 * 512 * 16;
static_assert((size_t)T * DFF * 2 <= (size_t)TP * 8192 * 2, "act alias");

constexpr int LDS_BYTES = 147456;
#ifndef REP_PHASE
#define REP_PHASE -1
#define REP_N 1
#define REPI 0
#endif
#ifndef P2M
#define P2M 15
#endif
#ifndef PHM
#define PHM 0xFFF
#endif

struct Params {
    const float *x_prompt, *x_sample, *p_prompt, *p_sample, *state_pool, *state_C, *state_n, *state_m, *g_pre_mix, *w_in, *b_i, *b_f,
        *w_pool_grp, *s_pool, *g_head, *w_pa, *w_pb, *w_out, *g_post_mix, *g_pre_ffn, *w_gate, *w_up, *w_down, *g_post_ffn, *w_ple, *w_ple_gate;
    float* out;
    unsigned char* ws;
};

__device__ __forceinline__ unsigned pk2(float lo, float hi) { unsigned r; asm("v_cvt_pk_bf16_f32 %0, %1, %2" : "=v"(r) : "v"(lo), "v"(hi)); return r; }
__device__ __forceinline__ float bflo(unsigned w) { return __uint_as_float(w << 16); }
__device__ __forceinline__ float bfhi(unsigned w) { return __uint_as_float(w & 0xffff0000u); }
__device__ __forceinline__ float bf1(bf16_t v) { return __uint_as_float(((unsigned)v) << 16); }
__device__ __forceinline__ float wave_sum(float v) {
#pragma unroll
    for (int o = 1; o < 64; o <<= 1) v += __shfl_xor(v, o);
    return v;
}
__device__ __forceinline__ float fsigmoid(float x) { return __builtin_amdgcn_rcpf(1.0f + __builtin_amdgcn_exp2f(-x * LOG2E)); }
__device__ __forceinline__ u32x4 pack8(const f32x4 v0, const f32x4 v1) { u32x4 w; w.x = pk2(v0[0], v0[1]); w.y = pk2(v0[2], v0[3]); w.z = pk2(v1[0], v1[1]); w.w = pk2(v1[2], v1[3]); return w; }
__device__ __forceinline__ f32x4 unlo(const u32x4 w) { return (f32x4){bflo(w.x), bfhi(w.x), bflo(w.y), bfhi(w.y)}; }
__device__ __forceinline__ f32x4 unhi(const u32x4 w) { return (f32x4){bflo(w.z), bfhi(w.z), bflo(w.w), bfhi(w.w)}; }
__device__ __forceinline__ f32x4 sig4(f32x4 v) { return (f32x4){fsigmoid(v[0]), fsigmoid(v[1]), fsigmoid(v[2]), fsigmoid(v[3])}; }
#define LDS_WAIT() asm volatile("s_waitcnt lgkmcnt(0)" ::: "memory")

constexpr int BK = 64, HALF = 128, HTB = HALF * BK * 2;
__device__ __forceinline__ int lds_byte(int r, int c) { const int st = (r >> 4) * 2 + (c >> 5), rr = r & 15, cc = c & 31, ob = rr * 64 + cc * 2; return st * 1024 + (ob ^ (((ob >> 9) & 1) << 5)); }
__device__ __forceinline__ void stage_rc(int b, int& R, int& C) { const int st = b / 1024, sb = b % 1024, swz = sb ^ (((sb >> 9) & 1) << 5); R = (st >> 1) * 16 + swz / 64; C = (st & 1) * 32 + (swz % 64) / 2; }
__device__ __forceinline__ int perm32(int rho) { const int n = rho >> 4, i = rho & 15; return 8 * (i >> 2) + 4 * n + (i & 3); }

struct Unit { const char* A; const char* B; int nt, pm, pn, z, mode, slot; };

__device__ __forceinline__ int xcd_remap(int L, int nwg) { const int q = nwg / 8, r = nwg % 8, xcd = L % 8, off = L / 8; return (xcd < r ? xcd * (q + 1) : r * (q + 1) + (xcd - r) * q) + off; }
__device__ __forceinline__ void grouped(int w, int nM, int nN, int& pm, int& pn) { const int nig = 8 * nN, gid = w / nig, fm = gid * 8, gsz = (nM - fm) < 8 ? (nM - fm) : 8; pm = fm + ((w % nig) % gsz); pn = (w % nig) / gsz; }

template <class Sched, class Epi>
__device__ __forceinline__ void gemm_phase(LAS unsigned char* lds, const int lda, const int ldb, const Sched& S, const Epi& E, float* part = nullptr, unsigned* flags = nullptr, unsigned target = 0u) {
    const int tid = threadIdx.x, wid = __builtin_amdgcn_readfirstlane(tid >> 6), lane = tid & 63, wr = wid >> 2, wc = wid & 3, fr = lane & 15, fq = lane >> 4;
    unsigned voffA[2], voffB[2];
#pragma unroll
    for (int i = 0; i < 2; ++i) { int R, C; stage_rc(tid * 16 + i * 8192, R, C); const int Rb = (R & ~31) + perm32(R & 31);
        voffA[i] = (unsigned)(R * lda + C) * 2u; voffB[i] = (unsigned)(Rb * ldb + C) * 2u; }
    const size_t kstep = (size_t)(BK * 2);
    const size_t hstepA = (size_t)HALF * lda * 2, hstepB = (size_t)HALF * ldb * 2;
    const unsigned ldsw = (unsigned)wid * 1024u;
    const int aoff = lds_byte(wr * 64 + fr, fq * 8), boff = lds_byte(wc * 32 + fr, fq * 8);
#define PG8_SA(b, h) (((b) * 2 + (h)) * HTB)
#define PG8_SB(b, h) ((4 + (b) * 2 + (h)) * HTB)
#define PG8_STAGE(bufoff, gbase, voff) do { _Pragma("unroll") for (int _i = 0; _i < 2; ++_i) \
        __builtin_amdgcn_global_load_lds((const unsigned*)((const char*)(gbase) + (voff)[_i]), (LAS unsigned*)(lds + (bufoff) + ldsw + _i * 8192), 16, 0, 0); } while (0)
#define PG8_LDA(dst, b, h) do { _Pragma("unroll") for (int m = 0; m < 4; ++m) _Pragma("unroll") for (int k = 0; k < 2; ++k) dst[m][k] = *(const LAS bf16x8*)(lds + PG8_SA(b, h) + aoff + m * 2048 + k * 1024); } while (0)
#define PG8_LDB(dst, b, h) do { _Pragma("unroll") for (int n = 0; n < 2; ++n) _Pragma("unroll") for (int k = 0; k < 2; ++k) dst[n][k] = *(const LAS bf16x8*)(lds + PG8_SB(b, h) + boff + n * 2048 + k * 1024); } while (0)
#define PG8_MMA(ai, bj, At, Bt) do { __builtin_amdgcn_s_setprio(1); _Pragma("unroll") for (int m = 0; m < 4; ++m) _Pragma("unroll") for (int n = 0; n < 2; ++n) _Pragma("unroll") for (int k = 0; k < 2; ++k) \
        acc[ai][bj][m][n] = __builtin_amdgcn_mfma_f32_16x16x32_bf16(Bt[n][k], At[m][k], acc[ai][bj][m][n], 0, 0, 0); __builtin_amdgcn_s_setprio(0); } while (0)
#define PG8_WAIT_V(n) asm volatile("s_waitcnt vmcnt(" #n ")" ::: "memory")
#define PG8_WAIT_L(n) asm volatile("s_waitcnt lgkmcnt(" #n ")" ::: "memory")
#define PG8_BAR __builtin_amdgcn_s_barrier()
#define PG8_SCHED __builtin_amdgcn_sched_barrier(0)
    Unit cur, nxt; int ui = 0;
    if (!S.next(0, cur)) return;
    f32x4 acc[2][2][4][2];
#pragma unroll
    for (int a = 0; a < 2; ++a)
#pragma unroll
        for (int b = 0; b < 2; ++b)
#pragma unroll
            for (int m = 0; m < 4; ++m)
#pragma unroll
                for (int n = 0; n < 2; ++n) acc[a][b][m][n] = (f32x4){0.f, 0.f, 0.f, 0.f};
    bf16x8 At[4][2], B0[2][2], B1[2][2];
    const char* cA = cur.A; const char* cB = cur.B;
    PG8_STAGE(PG8_SB(0, 0), cB, voffB); PG8_STAGE(PG8_SA(0, 0), cA, voffA); PG8_STAGE(PG8_SB(0, 1), cB + hstepB, voffB); PG8_STAGE(PG8_SA(0, 1), cA + hstepA, voffA);
    if (wr == 1) PG8_BAR;
    PG8_WAIT_V(4); PG8_BAR;
    PG8_STAGE(PG8_SB(1, 0), cB + kstep, voffB); PG8_STAGE(PG8_SA(1, 0), cA + kstep, voffA); PG8_STAGE(PG8_SB(1, 1), cB + hstepB + kstep, voffB);
    PG8_WAIT_V(6); PG8_BAR;
    for (;;) {
        const bool has_next = S.next(ui + 1, nxt);
        const char* nA = has_next ? nxt.A : cA; const char* nB = has_next ? nxt.B : cB;
        int nt = cur.nt; asm volatile("" : "+s"(nt));
        for (int t = 0; t < nt; t += 2) {
            const bool last = (t == nt - 2);
            const char* a1 = cA + (size_t)(t + 1) * kstep;
            const char* a2 = last ? nA : cA + (size_t)(t + 2) * kstep; const char* b2 = last ? nB : cB + (size_t)(t + 2) * kstep;
            asm volatile("" : "+s"(a1), "+s"(a2), "+s"(b2));
            const char* a3 = a2 + kstep; const char* b3 = b2 + kstep;
            PG8_LDB(B0, 0, 0); PG8_SCHED; PG8_LDA(At, 0, 0); PG8_STAGE(PG8_SA(1, 1), a1 + hstepA, voffA);
            PG8_WAIT_L(8); PG8_BAR; PG8_WAIT_L(0); PG8_MMA(0, 0, At, B0); PG8_BAR; PG8_SCHED;
            PG8_LDB(B1, 0, 1); PG8_STAGE(PG8_SB(0, 0), b2, voffB);
            PG8_BAR; PG8_WAIT_L(0); PG8_MMA(0, 1, At, B1); PG8_BAR;
            PG8_LDA(At, 0, 1); PG8_STAGE(PG8_SA(0, 0), a2, voffA);
            PG8_BAR; PG8_WAIT_L(0); PG8_MMA(1, 0, At, B0); PG8_BAR; PG8_SCHED;
            PG8_STAGE(PG8_SB(0, 1), b2 + hstepB, voffB);
            PG8_WAIT_V(6); PG8_BAR; PG8_MMA(1, 1, At, B1); PG8_BAR;
            PG8_LDB(B0, 1, 0); PG8_SCHED; PG8_LDA(At, 1, 0); PG8_STAGE(PG8_SA(0, 1), a2 + hstepA, voffA);
            PG8_WAIT_L(8); PG8_BAR; PG8_WAIT_L(0); PG8_MMA(0, 0, At, B0); PG8_BAR; PG8_SCHED;
            PG8_LDB(B1, 1, 1); PG8_STAGE(PG8_SB(1, 0), b3, voffB);
            PG8_BAR; PG8_WAIT_L(0); PG8_MMA(0, 1, At, B1); PG8_BAR;
            PG8_LDA(At, 1, 1); PG8_STAGE(PG8_SA(1, 0), a3, voffA);
            PG8_BAR; PG8_WAIT_L(0); PG8_MMA(1, 0, At, B0); PG8_BAR; PG8_SCHED;
            PG8_STAGE(PG8_SB(1, 1), b3 + hstepB, voffB);
            PG8_WAIT_V(6); PG8_BAR; PG8_MMA(1, 1, At, B1); PG8_BAR;
        }
        if constexpr (Sched::SK) {
            if (cur.mode == 2) {
                while (__hip_atomic_load(flags + cur.slot * 16, __ATOMIC_RELAXED, __HIP_MEMORY_SCOPE_AGENT) < target) __builtin_amdgcn_s_sleep(2);
                const __amdgpu_buffer_rsrc_t rl_ = __builtin_amdgcn_make_buffer_rsrc((void*)((char*)part + (size_t)cur.slot * 131072), (short)0, 131072, 0x00020000);
#pragma unroll
                for (int a = 0; a < 2; ++a) {
                    u32x4 tmp[8];
#pragma unroll
                    for (int j = 0; j < 8; ++j) tmp[j] = __builtin_amdgcn_raw_buffer_load_b128(rl_, tid * 16, (a * 8 + j) * 8192, 16);
                    asm volatile("s_waitcnt vmcnt(0)" ::: "memory");
#pragma unroll
                    for (int j = 0; j < 8; ++j) { acc[a][j >> 2][j & 3][0] += unlo(tmp[j]); acc[a][j >> 2][j & 3][1] += unhi(tmp[j]); }
                    __builtin_amdgcn_sched_barrier(0);
                }
            }
            __builtin_amdgcn_sched_barrier(0);
            if (cur.mode == 1) {
                const __amdgpu_buffer_rsrc_t rs = __builtin_amdgcn_make_buffer_rsrc((void*)((char*)part + (size_t)cur.slot * 131072), (short)0, 131072, 0x00020000);
#pragma unroll
                for (int a = 0; a < 2; ++a)
#pragma unroll
                    for (int b = 0; b < 2; ++b)
#pragma unroll
                        for (int m = 0; m < 4; ++m)
                            __builtin_amdgcn_raw_buffer_store_b128(pack8(acc[a][b][m][0], acc[a][b][m][1]), rs, tid * 16, ((a * 2 + b) * 4 + m) * 8192, 16);
                asm volatile("s_waitcnt vmcnt(0)" ::: "memory");
                if (lane == 0) __hip_atomic_fetch_add(flags + cur.slot * 16, 1u, __ATOMIC_RELAXED, __HIP_MEMORY_SCOPE_AGENT);
            } else {
                E(acc, cur, wr, wc, fr, fq);
            }
        } else {
            E(acc, cur, wr, wc, fr, fq);
        }
        if (!has_next) break;
#pragma unroll
        for (int a = 0; a < 2; ++a)
#pragma unroll
            for (int b = 0; b < 2; ++b)
#pragma unroll
                for (int m = 0; m < 4; ++m)
#pragma unroll
                    for (int n = 0; n < 2; ++n) acc[a][b][m][n] = (f32x4){0.f, 0.f, 0.f, 0.f};
        cur = nxt; cA = nA; cB = nB; ++ui;
    }
    PG8_WAIT_V(0);
    if (wr == 0) PG8_BAR;
    PG8_BAR;
#undef PG8_SA
#undef PG8_SB
#undef PG8_STAGE
#undef PG8_LDA
#undef PG8_LDB
#undef PG8_MMA
#undef PG8_WAIT_V
#undef PG8_WAIT_L
#undef PG8_BAR
#undef PG8_SCHED
}

typedef f32x4 Acc[2][2][4][2];

struct SchedU {
    static constexpr bool SK = false;
    int G, c, nM, nN, nt; const char* A; const char* B; size_t tA, tB;
    __device__ __forceinline__ void init(int G_, int c_, const void* A_, int lda, const void* B_, int ldb, int nM_, int nN_, int K) {
        G = G_; c = c_; nM = nM_; nN = nN_; nt = K / BK; A = (const char*)A_; B = (const char*)B_; tA = (size_t)256 * lda * 2; tB = (size_t)256 * ldb * 2; }
    __device__ __forceinline__ bool next(int i, Unit& u) const { u.mode = 0; u.slot = 0;
        const int nwg = nM * nN; const long L = (long)i * G + c; if (L >= nwg) return false;
        const int w = xcd_remap((int)L, nwg); int pm, pn; grouped(w, nM, nN, pm, pn);
        u.A = A + (size_t)pm * tA; u.B = B + (size_t)pn * tB; u.nt = nt; u.pm = pm; u.pn = pn; u.z = 0; return true; }
};
struct SchedK {
    static constexpr bool SK = true;
    int nM, nN, n; const char* A; const char* B; size_t tA, tB; int s0, s1, cpos;
    __device__ __forceinline__ void init(int G, int bid, const void* A_, int lda, const void* B_, int ldb, int nM_, int nN_, int K) {
        nM = nM_; nN = nN_; n = K / (2 * BK); A = (const char*)A_; B = (const char*)B_; tA = (size_t)256 * lda * 2; tB = (size_t)256 * ldb * 2;
        cpos = (G % 8 == 0) ? (bid % 8) * (G / 8) + bid / 8 : bid;
        const long TT = (long)nM * nN * n; s0 = (int)((long)cpos * TT / G); s1 = (int)((long)(cpos + 1) * TT / G); }
    __device__ __forceinline__ void piece(Unit& u, int ui, int t0, int nt_, int mode, int slot) const {
        int pm, pn; grouped(ui, nM, nN, pm, pn);
        u.A = A + (size_t)pm * tA + (size_t)t0 * (4 * BK); u.B = B + (size_t)pn * tB + (size_t)t0 * (4 * BK); u.nt = 2 * nt_; u.pm = pm; u.pn = pn; u.z = 0; u.mode = mode; u.slot = slot; }
    __device__ __forceinline__ bool next(int i, Unit& u) const {
        const int u0 = s0 / n, o0 = s0 % n, u1 = s1 / n, e = s1 % n, fstart = (o0 > 0) ? u0 + 1 : u0, nfull = u1 - fstart;
        int k = i;
        if (e > 0) { if (k == 0) { piece(u, u1, 0, e, 1, cpos); return true; } --k; }
        if (k < nfull) { piece(u, fstart + k, 0, n, 0, 0); return true; }
        k -= nfull;
        if (o0 > 0 && k == 0) { piece(u, u0, o0, n - o0, 2, cpos - 1); return true; }
        return false; }
};
struct SchedP1 {
    static constexpr bool SK = false;
    int G, c; const char* h1; const char* WinT;
    __device__ __forceinline__ bool next(int i, Unit& u) const { u.mode = 0; u.slot = 0;
        const int nwg = 1496; const long L = (long)i * G + c; if (L >= nwg) return false;
        int w = xcd_remap((int)L, nwg); int pm, pn; const size_t ts = (size_t)256 * 2048 * 2;
        u.nt = 32; u.z = 0;
        if (w < 384) { grouped(w, 32, 12, pm, pn); }
        else if (w < 1152) { grouped(w - 384, 32, 24, pm, pn); pn += 20; }
        else if (w < 1240) { grouped(w - 1152, 2, 44, pm, pn); pm += 32; }
        else { grouped(w - 1240, 8, 32, pm, pn); u.z = 1; u.A = WinT + (size_t)(12 + pm) * ts; u.B = h1 + (size_t)pn * ts; u.pm = pm; u.pn = pn; return true; }
        u.A = h1 + (size_t)pm * ts; u.B = WinT + (size_t)pn * ts; u.pm = pm; u.pn = pn; return true; }
};
struct SchedQK {
    static constexpr bool SK = false;
    int G, c; const char* q; const char* k;
    __device__ __forceinline__ bool next(int i, Unit& u) const { u.mode = 0; u.slot = 0;
        const long L = (long)i * G + c; if (L >= 576) return false;
        const int bh = (int)L / 36, tri = (int)L % 36; int pm = 0, rem = tri;
        while (rem > pm) { rem -= pm + 1; ++pm; }
        const int pn = rem, b = bh >> 2, h = bh & 3;
        u.A = q + ((size_t)(b * 2048 + pm * 256) * 1024 + h * 256) * 2; u.B = k + ((size_t)(b * 2048 + pn * 256) * 1024 + h * 256) * 2;
        u.nt = 4; u.pm = pm; u.pn = pn; u.z = bh; return true; }
};
struct SchedSV {
    static constexpr bool SK = false;
    int G, c; const char* S; const char* vT; const char* kwT;
    __device__ __forceinline__ bool next(int i, Unit& u) const { u.mode = 0; u.slot = 0;
        if ((long)i * G >= 288) return false;
        const int o = (i & 1) ? (i * G + (G - 1 - c)) : (i * G + c); if (o >= 288) return false;
        if (o < 32) { const int bh = o >> 1, pn = o & 1, b = bh >> 2, h = bh & 3;
            u.A = kwT + ((size_t)(h * 256) * TP + b * 2048) * 2; u.B = vT + ((size_t)(h * 512 + pn * 256) * TP + b * 2048) * 2; u.nt = 32; u.pm = 0; u.pn = pn; u.z = 16 + bh; return true; }
        const int o2 = o - 32, pm = 7 - (o2 >> 5), rem = o2 & 31, bh = rem >> 1, pn = rem & 1, b = bh >> 2, h = bh & 3;
        u.A = S + ((size_t)(b * 2048 + pm * 256) * 8192 + h * 2048) * 2; u.B = vT + ((size_t)(h * 512 + pn * 256) * TP + b * 2048) * 2; u.nt = 4 * (pm + 1); u.pm = pm; u.pn = pn; u.z = bh; return true; }
};
struct SchedPool {
    static constexpr bool SK = false;
    int G, c; const char* zb; const char* Wg;
    __device__ __forceinline__ bool next(int i, Unit& u) const { u.mode = 0; u.slot = 0;
        const long L = (long)i * G + c; if (L >= 136) return false;
        const int g = (int)L / 34, pm = (int)L % 34;
        u.A = zb + ((size_t)pm * 256 * 1024 + g * 256) * 2; u.B = Wg + (size_t)g * 65536 * 2; u.nt = 4; u.pm = pm; u.pn = 0; u.z = g; return true; }
};

struct SchedPe {
    static constexpr bool SK = false;
    int G, c; const char* p; const char* W;
    __device__ __forceinline__ bool next(int i, Unit& u) const { u.mode = 0; u.slot = 0;
        const int skip = (272 - G > 0 && 272 - G < G) ? 272 - G : 0; if (c < skip) return false;
        const long L = (long)i * (G - skip) + (c - skip); if (L >= 272) return false;
        const int pm = (int)L % 34, pn = (int)L / 34;
        u.A = p + (size_t)pm * 256 * PLE * 2; u.B = W + (size_t)pn * 256 * PLE * 2; u.nt = 4; u.pm = pm; u.pn = pn; u.z = 0; return true; }
};

#define EPI_LAUNDER int lr_ = 64 * wr + fr, lc_ = 32 * wc + 8 * fq; asm volatile("" : "+v"(lr_), "+v"(lc_));
#define EPI_ROWS_BEGIN _Pragma("unroll") for (int ai = 0; ai < 2; ++ai) _Pragma("unroll") for (int m = 0; m < 4; ++m) { const int rl = 128 * ai + 16 * m + lr_;
#define EPI_ROWS_END }

struct EpiP1 {
    bf16_t *u, *q, *k, *v, *so, *ga, *gb, *vT;
    __device__ __forceinline__ void operator()(const Acc& acc, const Unit& un, int wr, int wc, int fr, int fq) const { EPI_LAUNDER
        bf16_t* dst; int ldc; float scale = 1.f; bool sg = false; long row0 = (long)un.pm * 256;
        if (un.z == 1) { dst = vT + un.pn * 256; ldc = TP; }
        else { const int tn = un.pn;
            if (tn < 4) { dst = u + tn * 256; ldc = 1024; }
            else if (tn < 8) { dst = q + (tn - 4) * 256; ldc = 1024; }
            else if (tn < 12) { dst = k + (tn - 8) * 256; ldc = 1024; scale = 0.0625f; }
            else if (tn < 20) { dst = v + (tn - 12) * 256; ldc = 2048; row0 -= TP; }
            else if (tn < 28) { dst = so + (tn - 20) * 256; ldc = 2048; sg = true; }
            else if (tn < 36) { dst = ga + (tn - 28) * 256; ldc = 2048; sg = true; }
            else { dst = gb + (tn - 36) * 256; ldc = 2048; sg = true; } }
        const int cl0 = lc_;
        EPI_ROWS_BEGIN
            bf16_t* rp = dst + (size_t)(row0 + rl) * ldc + cl0;
#pragma unroll
            for (int bj = 0; bj < 2; ++bj) { f32x4 v0 = acc[ai][bj][m][0], v1 = acc[ai][bj][m][1];
                if (sg) { v0 = sig4(v0); v1 = sig4(v1); } else { v0 = v0 * scale; v1 = v1 * scale; }
                *(u32x4*)(rp + bj * HALF) = pack8(v0, v1); }
        EPI_ROWS_END
    }
};
struct EpiBf {
    bf16_t* dst; int ldc;
    __device__ __forceinline__ void operator()(const Acc& acc, const Unit& un, int wr, int wc, int fr, int fq) const { EPI_LAUNDER
        bf16_t* d0 = dst + (size_t)un.pm * 256 * ldc + un.pn * 256 + lc_;
        EPI_ROWS_BEGIN
            bf16_t* rp = d0 + (size_t)rl * ldc;
#pragma unroll
            for (int bj = 0; bj < 2; ++bj) *(u32x4*)(rp + bj * HALF) = pack8(acc[ai][bj][m][0], acc[ai][bj][m][1]);
        EPI_ROWS_END
    }
};
struct EpiS {
    bf16_t* S; const float* su; const float* sw; float* denp;
    __device__ __forceinline__ void operator()(const Acc& acc, const Unit& un, int wr, int wc, int fr, int fq) const { EPI_LAUNDER
        const int bh = un.z, b = bh >> 2, h = bh & 3; const bool diag = (un.pm == un.pn);
        const int cl0 = lc_;
        f32x4 ww[2][2];
#pragma unroll
        for (int bj = 0; bj < 2; ++bj)
#pragma unroll
            for (int n = 0; n < 2; ++n) ww[bj][n] = *(const f32x4*)(sw + bh * 2048 + un.pn * 256 + bj * HALF + cl0 + 4 * n);
        float uu8[2][4];
#pragma unroll
        for (int ai = 0; ai < 2; ++ai)
#pragma unroll
            for (int m = 0; m < 4; ++m) uu8[ai][m] = su[bh * 2048 + un.pm * 256 + 128 * ai + 16 * m + lr_];
        EPI_ROWS_BEGIN
            const int srow = un.pm * 256 + rl; const float uu = uu8[ai][m]; float rs = 0.f; const int lim = diag ? rl : 0x7fffffff;
            bf16_t* rp = S + (size_t)(b * 2048 + srow) * 8192 + h * 2048 + un.pn * 256 + cl0;
#pragma unroll
            for (int bj = 0; bj < 2; ++bj) { f32x4 o[2];
#pragma unroll
                for (int n = 0; n < 2; ++n)
#pragma unroll
                    for (int e = 0; e < 4; ++e) { float val = acc[ai][bj][m][n][e] * __builtin_amdgcn_exp2f(uu + ww[bj][n][e]);
                        if (bj * HALF + cl0 + 4 * n + e > lim) val = 0.f;
                        o[n][e] = val; rs += val; }
                *(u32x4*)(rp + bj * HALF) = pack8(o[0], o[1]); }
            rs += __shfl_xor(rs, 16); rs += __shfl_xor(rs, 32);
            if (fq == 0) denp[(size_t)(bh * 2048 + srow) * 32 + un.pn * 4 + wc] = rs;
        EPI_ROWS_END
    }
};
struct EpiSV {
    bf16_t* num; float* Cp;
    __device__ __forceinline__ void operator()(const Acc& acc, const Unit& un, int wr, int wc, int fr, int fq) const { EPI_LAUNDER
        const int cl0 = lc_;
        if (un.z < 16) { const int bh = un.z, b = bh >> 2, h = bh & 3;
            bf16_t* d0 = num + (size_t)(b * 2048 + un.pm * 256) * 2048 + h * 512 + un.pn * 256 + cl0;
            EPI_ROWS_BEGIN
                bf16_t* rp = d0 + (size_t)rl * 2048;
#pragma unroll
                for (int bj = 0; bj < 2; ++bj) *(u32x4*)(rp + bj * HALF) = pack8(acc[ai][bj][m][0], acc[ai][bj][m][1]);
            EPI_ROWS_END
        } else { const int bh = un.z - 16;
            float* d0 = Cp + (size_t)bh * 256 * 512 + un.pn * 256 + cl0;
            EPI_ROWS_BEGIN
                float* rp = d0 + (size_t)rl * 512;
#pragma unroll
                for (int bj = 0; bj < 2; ++bj) { *(f32x4*)(rp + bj * HALF) = acc[ai][bj][m][0]; *(f32x4*)(rp + bj * HALF + 4) = acc[ai][bj][m][1]; }
            EPI_ROWS_END
        }
    }
};
struct EpiPool {
    bf16_t* a; const float* sp;
    __device__ __forceinline__ void operator()(const Acc& acc, const Unit& un, int wr, int wc, int fr, int fq) const { EPI_LAUNDER
        const int c0 = un.z * 256 + lc_;
        f32x4 s[2][2];
#pragma unroll
        for (int bj = 0; bj < 2; ++bj)
#pragma unroll
            for (int n = 0; n < 2; ++n) s[bj][n] = *(const f32x4*)(sp + c0 + bj * HALF + 4 * n);
        EPI_ROWS_BEGIN
            bf16_t* rp = a + (size_t)(un.pm * 256 + rl) * 1024 + c0;
#pragma unroll
            for (int bj = 0; bj < 2; ++bj) *(u32x4*)(rp + bj * HALF) = pack8(acc[ai][bj][m][0] * s[bj][0], acc[ai][bj][m][1] * s[bj][1]);
        EPI_ROWS_END
    }
};
struct EpiPA {
    bf16_t* T1; const bf16_t* ga;
    __device__ __forceinline__ void operator()(const Acc& acc, const Unit& un, int wr, int wc, int fr, int fq) const { EPI_LAUNDER
        const size_t o0 = (size_t)un.pm * 256 * 2048 + un.pn * 256 + lc_;
        u32x4 gg[2][4][2];
#pragma unroll
        for (int ai = 0; ai < 2; ++ai)
#pragma unroll
            for (int m = 0; m < 4; ++m)
#pragma unroll
                for (int bj = 0; bj < 2; ++bj) gg[ai][m][bj] = *(const u32x4*)(ga + o0 + (size_t)(128 * ai + 16 * m + lr_) * 2048 + bj * HALF);
        EPI_ROWS_BEGIN
            const size_t ro = o0 + (size_t)rl * 2048;
#pragma unroll
            for (int bj = 0; bj < 2; ++bj) { const u32x4 g = gg[ai][m][bj];
                *(u32x4*)(T1 + ro + bj * HALF) = pack8(acc[ai][bj][m][0] * unlo(g), acc[ai][bj][m][1] * unhi(g)); }
        EPI_ROWS_END
    }
};
struct EpiPB {
    bf16_t* mg; const bf16_t* T1; const bf16_t* gb;
    __device__ __forceinline__ void operator()(const Acc& acc, const Unit& un, int wr, int wc, int fr, int fq) const { EPI_LAUNDER
        const size_t o0 = (size_t)un.pm * 256 * 2048 + un.pn * 256 + lc_;
#pragma unroll
        for (int ai = 0; ai < 2; ++ai) {
            u32x4 g4[4][2], t4[4][2];
#pragma unroll
            for (int m = 0; m < 4; ++m)
#pragma unroll
                for (int bj = 0; bj < 2; ++bj) { const size_t ro = o0 + (size_t)(128 * ai + 16 * m + lr_) * 2048 + bj * HALF; g4[m][bj] = *(const u32x4*)(gb + ro); t4[m][bj] = *(const u32x4*)(T1 + ro); }
            __builtin_amdgcn_sched_barrier(0);
#pragma unroll
            for (int m = 0; m < 4; ++m) { const size_t ro = o0 + (size_t)(128 * ai + 16 * m + lr_) * 2048;
#pragma unroll
                for (int bj = 0; bj < 2; ++bj) *(u32x4*)(mg + ro + bj * HALF) = pack8(unlo(t4[m][bj]) + acc[ai][bj][m][0] * unlo(g4[m][bj]), unhi(t4[m][bj]) + acc[ai][bj][m][1] * unhi(g4[m][bj]));
                __builtin_amdgcn_sched_barrier(0); }
        }
    }
};
struct EpiSq {
    bf16_t* dst; float* ssq;
    __device__ __forceinline__ void operator()(const Acc& acc, const Unit& un, int wr, int wc, int fr, int fq) const { EPI_LAUNDER
        const size_t o0 = (size_t)un.pm * 256 * 2048 + un.pn * 256 + lc_;
        EPI_ROWS_BEGIN
            const size_t ro = o0 + (size_t)rl * 2048; float rs = 0.f;
#pragma unroll
            for (int bj = 0; bj < 2; ++bj) { const f32x4 v0 = acc[ai][bj][m][0], v1 = acc[ai][bj][m][1];
                rs += v0[0] * v0[0] + v0[1] * v0[1] + v0[2] * v0[2] + v0[3] * v0[3] + v1[0] * v1[0] + v1[1] * v1[1] + v1[2] * v1[2] + v1[3] * v1[3];
                *(u32x4*)(dst + ro + bj * HALF) = pack8(v0, v1); }
            rs += __shfl_xor(rs, 16); rs += __shfl_xor(rs, 32);
            if (fq == 0) ssq[(size_t)(un.pm * 256 + rl) * 32 + un.pn * 4 + wc] = rs;
        EPI_ROWS_END
    }
};
struct EpiSwi {
    bf16_t* act; const float* rs;
    __device__ __forceinline__ void operator()(const Acc& acc, const Unit& un, int wr, int wc, int fr, int fq) const { EPI_LAUNDER
        bf16_t* d0 = act + (size_t)un.pm * 256 * DFF + un.pn * 128 + lc_;
        float r8[2][4];
#pragma unroll
        for (int ai = 0; ai < 2; ++ai)
#pragma unroll
            for (int m = 0; m < 4; ++m) r8[ai][m] = rs[un.pm * 256 + 128 * ai + 16 * m + lr_];
        EPI_ROWS_BEGIN
            const float r = r8[ai][m];
            const f32x4 g0 = acc[ai][0][m][0] * r, g1 = acc[ai][0][m][1] * r, u0 = acc[ai][1][m][0] * r, u1 = acc[ai][1][m][1] * r;
            *(u32x4*)(d0 + (size_t)rl * DFF) = pack8(g0 * sig4(g0) * u0, g1 * sig4(g1) * u1);
        EPI_ROWS_END
    }
};
struct EpiPle {
    float* y; const bf16_t* x2; const bf16_t* pe;
    __device__ __forceinline__ void operator()(const Acc& acc, const Unit& un, int wr, int wc, int fr, int fq) const { EPI_LAUNDER
        const size_t o0 = (size_t)un.pm * 256 * 2048 + un.pn * 256 + lc_;
#pragma unroll
        for (int ai = 0; ai < 2; ++ai) {
            u32x4 p4[4][2], x4[4][2];
#pragma unroll
            for (int m = 0; m < 4; ++m)
#pragma unroll
                for (int bj = 0; bj < 2; ++bj) { const size_t ro = o0 + (size_t)(128 * ai + 16 * m + lr_) * 2048 + bj * HALF; p4[m][bj] = *(const u32x4*)(pe + ro); x4[m][bj] = *(const u32x4*)(x2 + ro); }
            __builtin_amdgcn_sched_barrier(0);
#pragma unroll
            for (int m = 0; m < 4; ++m) { const size_t ro = o0 + (size_t)(128 * ai + 16 * m + lr_) * 2048;
#pragma unroll
                for (int bj = 0; bj < 2; ++bj) {
                    *(f32x4*)(y + ro + bj * HALF) = unlo(x4[m][bj]) + sig4(acc[ai][bj][m][0]) * unlo(p4[m][bj]);
                    *(f32x4*)(y + ro + bj * HALF + 4) = unhi(x4[m][bj]) + sig4(acc[ai][bj][m][1]) * unhi(p4[m][bj]); }
                __builtin_amdgcn_sched_barrier(0); }
        }
    }
};

__device__ __forceinline__ void transpose_item(const float* src, int ldw, bf16_t* dst, int ldd, LAS float* scr, int lane, const float* ks = nullptr) {
    f32x4 v[8];
#pragma unroll
    for (int i = 0; i < 8; ++i) v[i] = *(const f32x4*)(src + (size_t)(i * 8 + (lane >> 3)) * ldw + (lane & 7) * 4);
    if (ks) {
        float kv[8];
#pragma unroll
        for (int i = 0; i < 8; ++i) kv[i] = ks[i * 8 + (lane >> 3)];
#pragma unroll
        for (int i = 0; i < 8; ++i) v[i] = v[i] * kv[i]; }
#pragma unroll
    for (int i = 0; i < 8; ++i) { LAS float* s = scr + (i * 8 + (lane >> 3)) * 33 + (lane & 7) * 4; s[0] = v[i][0]; s[1] = v[i][1]; s[2] = v[i][2]; s[3] = v[i][3]; }
    LDS_WAIT();
    const int c = lane & 7;
#pragma unroll
    for (int j = 0; j < 4; ++j) { const int n = (lane >> 3) + 8 * j; const LAS float* s = scr + (8 * c) * 33 + n;
        u32x4 o; o.x = pk2(s[0 * 33], s[1 * 33]); o.y = pk2(s[2 * 33], s[3 * 33]); o.z = pk2(s[4 * 33], s[5 * 33]); o.w = pk2(s[6 * 33], s[7 * 33]);
        *(u32x4*)(dst + (size_t)n * ldd + 8 * c) = o; }
    LDS_WAIT();
}

__device__ __forceinline__ void weight_item(const Params& P, int it, LAS float* scr, int lane) {
    unsigned char* ws = P.ws;
    int r = it;
    if (r < 7168) { const int kb = r / 224, nb = r % 224; transpose_item(P.w_in + (size_t)kb * 64 * NIN + nb * 32, NIN, (bf16_t*)(ws + O_WIN) + (size_t)(nb * 32) * DM + kb * 64, DM, scr, lane); return; } r -= 7168;
    if (r < 4096) { const int kb = r / 128, nb = r % 128; transpose_item(P.w_in + (size_t)kb * 64 * NIN + 7176 + nb * 32, NIN, (bf16_t*)(ws + O_WIN) + (size_t)(7168 + nb * 32) * DM + kb * 64, DM, scr, lane); return; } r -= 4096;
    if (r < 5632) { const int kb = r / 176, nb = r % 176, n0 = nb * 32; transpose_item(P.w_gate + (size_t)kb * 64 * DFF + n0, DFF, (bf16_t*)(ws + O_WGU) + (size_t)((n0 >> 7) * 256 + (n0 & 127)) * DM + kb * 64, DM, scr, lane, P.g_pre_ffn + kb * 64); return; } r -= 5632;
    if (r < 5632) { const int kb = r / 176, nb = r % 176, n0 = nb * 32; transpose_item(P.w_up + (size_t)kb * 64 * DFF + n0, DFF, (bf16_t*)(ws + O_WGU) + (size_t)((n0 >> 7) * 256 + 128 + (n0 & 127)) * DM + kb * 64, DM, scr, lane, P.g_pre_ffn + kb * 64); return; } r -= 5632;
    if (r < 5632) { const int kb = r / 64, nb = r % 64; transpose_item(P.w_down + (size_t)kb * 64 * DM + nb * 32, DM, (bf16_t*)(ws + O_WDN) + (size_t)(nb * 32) * DFF + kb * 64, DFF, scr, lane); return; } r -= 5632;
    if (r < 1024) { const int kb = r / 64, nb = r % 64; transpose_item(P.w_pa + (size_t)kb * 64 * DM + nb * 32, DM, (bf16_t*)(ws + O_WPA) + (size_t)(nb * 32) * DP + kb * 64, DP, scr, lane); return; } r -= 1024;
    if (r < 2048) { const int kb = r / 64, nb = r % 64; transpose_item(P.w_pb + (size_t)kb * 64 * DM + nb * 32, DM, (bf16_t*)(ws + O_WPB) + (size_t)(nb * 32) * DM + kb * 64, DM, scr, lane); return; } r -= 2048;
    if (r < 2048) { const int kb = r / 64, nb = r % 64; transpose_item(P.w_out + (size_t)kb * 64 * DM + nb * 32, DM, (bf16_t*)(ws + O_WOUT) + (size_t)(nb * 32) * DM + kb * 64, DM, scr, lane); return; } r -= 2048;
    if (r < 2048) { const int kb = r / 64, nb = r % 64; transpose_item(P.w_ple_gate + (size_t)kb * 64 * DM + nb * 32, DM, (bf16_t*)(ws + O_WPG) + (size_t)(nb * 32) * DM + kb * 64, DM, scr, lane); return; } r -= 2048;
    if (r < 256) { const int kb = r / 64, nb = r % 64; transpose_item(P.w_ple + (size_t)kb * 64 * DM + nb * 32, DM, (bf16_t*)(ws + O_WPLE) + (size_t)(nb * 32) * PLE + kb * 64, PLE, scr, lane); return; } r -= 256;
    { const int g = r / 32, rr = r % 32, kb = rr / 8, nb = rr % 8;
      transpose_item(P.w_pool_grp + (size_t)g * 65536 + (size_t)kb * 64 * 256 + nb * 32, 256, (bf16_t*)(ws + O_WGRP) + (size_t)g * 65536 + (size_t)(nb * 32) * 256 + kb * 64, 256, scr, lane); }
}
constexpr int N_WITEMS = 7168 + 4096 + 5632 * 3 + 1024 + 2048 * 3 + 256 + 128;
constexpr int W_DN0 = 7168 + 4096 + 5632 * 2, W_PB0 = 7168 + 4096 + 5632 * 3 + 1024, W_LATE0 = W_PB0 + 2048, W_LATE1 = W_LATE0 + 2048 * 2;

template <int W>
__device__ __forceinline__ void pool_z_item(const Params& P, const bf16_t* ub, bf16_t* zb, int t, int ch0) {
    f32x4 sa = {0.f, 0.f, 0.f, 0.f}, sb = {0.f, 0.f, 0.f, 0.f}; float cnt; u32x4 cur;
    if (t < TP) { const int s = t & 2047, n = (s + 1 < W) ? s + 1 : W; cnt = (float)n;
        u32x4 r[W];
#pragma unroll
        for (int i = 0; i < W; ++i) r[i] = (i < n) ? *(const u32x4*)(ub + (size_t)(t - i) * 1024 + ch0) : (u32x4){0u, 0u, 0u, 0u};
        cur = r[0];
#pragma unroll
        for (int i = 0; i < W; ++i) { sa += unlo(r[i]); sb += unhi(r[i]); } }
    else { const int bs = (t - TP) >> 2, s = (t - TP) & 3; cnt = (float)W;
        cur = *(const u32x4*)(ub + (size_t)t * 1024 + ch0);
#pragma unroll
        for (int i = 0; i < W; ++i) { const int e = 15 + s - i;
            if (e >= 15) { const u32x4 r = *(const u32x4*)(ub + (size_t)(TP + bs * 4 + (e - 15)) * 1024 + ch0); sa += unlo(r); sb += unhi(r); }
            else { const float* sp = P.state_pool + ((size_t)bs * 15 + e) * 1024 + ch0; sa += *(const f32x4*)sp; sb += *(const f32x4*)(sp + 4); } } }
    const float ic = 1.f / cnt;
    *(u32x4*)(zb + (size_t)t * 1024 + ch0) = pack8(sa * ic - unlo(cur), sb * ic - unhi(cur));
}

__device__ __forceinline__ void sample_item(const Params& P, int item, LAS float* L) {
    const int tid = threadIdx.x, lane = tid & 63, wid = tid >> 6;
    const int b = item >> 2, h = item & 3, t0 = TP + b * 4;
    unsigned char* ws = P.ws;
    const bf16_t* qb = (const bf16_t*)(ws + O_Q); const bf16_t* kb = (const bf16_t*)(ws + O_K); const bf16_t* vb = (const bf16_t*)(ws + O_V);
    const float* igp = (const float*)(ws + O_IG); const float* lfp = (const float*)(ws + O_LF);
    LAS float* qs = L;
    LAS float* ks = L + 1024;
    LAS float* vs = L + 2048;
    LAS float* n0s = L + 4096;
    LAS float* red = L + 4352;
    LAS float* nred = L + 4608;
    for (int idx = tid; idx < 1024; idx += 512) { const int t = idx >> 8, d = idx & 255;
        qs[d * 4 + t] = bf1(qb[(size_t)(t0 + t) * 1024 + h * 256 + d]); ks[d * 4 + t] = bf1(kb[(size_t)(t0 + t) * 1024 + h * 256 + d]); }
    for (int idx = tid; idx < 2048; idx += 512) { const int t = idx >> 9, e = idx & 511; vs[idx] = bf1(vb[(size_t)(b * 4 + t) * 2048 + h * 512 + e]); }
    if (tid < 256) n0s[tid] = P.state_n[(size_t)(b * 4 + h) * 256 + tid];
    float bc[4], igv[4], mt[4], inter[4], Dt[4][4];
    const float m0 = P.state_m[b * 4 + h];
    { float cs = 0.f;
#pragma unroll
      for (int t = 0; t < 4; ++t) { cs += lfp[(t0 + t) * 4 + h]; bc[t] = cs; igv[t] = igp[(t0 + t) * 4 + h]; } }
#pragma unroll
    for (int t = 0; t < 4; ++t) { const float a = bc[t] + m0; float mm = a;
#pragma unroll
        for (int j = 0; j < 4; ++j) if (j <= t) mm = fmaxf(mm, bc[t] - bc[j] + igv[j]);
        mt[t] = mm; inter[t] = __expf(a - mm);
#pragma unroll
        for (int j = 0; j < 4; ++j) Dt[t][j] = (j <= t) ? __expf(bc[t] - bc[j] + igv[j] - mm) : 0.f; }
    const float m_new = mt[3], bL = bc[3], decay = __expf(bL + m0 - m_new);
    float wk[4];
#pragma unroll
    for (int j = 0; j < 4; ++j) wk[j] = __expf(bL - bc[j] + igv[j] - m_new);
    __syncthreads();
    for (int dt = wid; dt < 20; dt += 8) { float s = 0.f;
        if (dt < 16) { const int t = dt >> 2, j = dt & 3;
#pragma unroll
            for (int i = 0; i < 4; ++i) { const int d = lane + 64 * i; s += qs[d * 4 + t] * ks[d * 4 + j]; } }
        else { const int t = dt - 16;
#pragma unroll
            for (int i = 0; i < 4; ++i) { const int d = lane + 64 * i; s += qs[d * 4 + t] * n0s[d]; } }
        s = wave_sum(s); if (lane == 0) red[dt] = s; }
    __syncthreads();
    LAS float* sc = L + 4384;
    if (tid == 0) {
#pragma unroll
        for (int t = 0; t < 4; ++t) { float ds = inter[t] * red[16 + t];
#pragma unroll
            for (int j = 0; j < 4; ++j) { const float sv = red[t * 4 + j] * Dt[t][j]; sc[8 + t * 4 + j] = sv; ds += sv; }
            sc[t] = inter[t]; sc[4 + t] = fmaxf(fabsf(ds), __expf(-mt[t])); sc[24 + t] = wk[t]; }
    }
    __syncthreads();
    for (int idx = tid; idx < 1024; idx += 512) ks[idx] *= sc[24 + (idx & 3)];
    __syncthreads();
    const int cgp = tid & 127, dg = tid >> 7;
    f32x4 vv[4], nq[4];
#pragma unroll
    for (int j = 0; j < 4; ++j) { vv[j] = *(const LAS f32x4*)(vs + j * 512 + cgp * 4); nq[j] = (f32x4){0.f, 0.f, 0.f, 0.f}; }
    const f32x4* Cin = (const f32x4*)(P.state_C + (size_t)(b * 4 + h) * 256 * 512) + cgp;
    f32x4* Cout = (f32x4*)(P.out + OUT_CS + (size_t)(b * 4 + h) * 256 * 512) + cgp;
    for (int d0 = dg * 64; d0 < dg * 64 + 64; d0 += 16) {
        f32x4 cc[16];
#pragma unroll
        for (int i = 0; i < 16; ++i) cc[i] = __builtin_nontemporal_load(Cin + (size_t)(d0 + i) * 128);
#pragma unroll
        for (int i = 0; i < 16; ++i) { const f32x4 qd = *(const LAS f32x4*)(qs + (d0 + i) * 4), kd = *(const LAS f32x4*)(ks + (d0 + i) * 4);
            nq[0] += cc[i] * qd[0]; nq[1] += cc[i] * qd[1]; nq[2] += cc[i] * qd[2]; nq[3] += cc[i] * qd[3];
            f32x4 cn = cc[i] * decay + vv[0] * kd[0] + vv[1] * kd[1] + vv[2] * kd[2] + vv[3] * kd[3];
            __builtin_nontemporal_store(cn, Cout + (size_t)(d0 + i) * 128); }
    }
#pragma unroll
    for (int t = 0; t < 4; ++t) *(LAS f32x4*)(nred + (dg * 4 + t) * 512 + cgp * 4) = nq[t];
    __syncthreads();
    bf16_t* numb = (bf16_t*)(ws + O_NUM);
#pragma unroll
    for (int i = 0; i < 4; ++i) { const int idx = tid + 512 * i, t = idx >> 9, e = idx & 511;
        const float nqs = nred[(0 * 4 + t) * 512 + e] + nred[(1 * 4 + t) * 512 + e] + nred[(2 * 4 + t) * 512 + e] + nred[(3 * 4 + t) * 512 + e];
        const float it_ = sc[t], dd = sc[4 + t], s0 = sc[8 + t * 4], s1 = sc[9 + t * 4], s2 = sc[10 + t * 4], s3 = sc[11 + t * 4];
        const float val = it_ * nqs + s0 * vs[e] + s1 * vs[512 + e] + s2 * vs[1024 + e] + s3 * vs[1536 + e];
        const float hv = val / dd;
        numb[(size_t)(t0 + t) * 2048 + h * 512 + e] = (bf16_t)(pk2(hv, 0.f) & 0xffffu); }
    if (tid < 256) { const f32x4 kd = *(const LAS f32x4*)(ks + tid * 4);
        P.out[OUT_NS + (size_t)(b * 4 + h) * 256 + tid] = decay * n0s[tid] + kd[0] + kd[1] + kd[2] + kd[3]; }
    if (tid == 0) P.out[OUT_MS + b * 4 + h] = m_new;
    __syncthreads();
}


#define XB_TMO      128
#define XB_XCNT(j)  (256  + 64 * (j))
#define XB_XSUB(j)  (1280 + 64 * (j))
#define XB_XGEN(j)  (2304 + 64 * (j))
#define XB_TOP      3328
#define XB_TOPGEN   3392
#define XCD_BAR_WORDS 3456
#define XB_SPIN_CAP (1u << 22)
__device__ __forceinline__ unsigned xb_ld(unsigned* p)              { return __hip_atomic_load(p, __ATOMIC_RELAXED, __HIP_MEMORY_SCOPE_AGENT); }
__device__ __forceinline__ unsigned xb_add(unsigned* p, unsigned v) { return __hip_atomic_fetch_add(p, v, __ATOMIC_RELAXED, __HIP_MEMORY_SCOPE_AGENT); }
__device__ __forceinline__ unsigned xb_xcc_id() { return (unsigned)__builtin_amdgcn_s_getreg((3 << 11) | 20) & 0xFu; }
#define XB_SPIN(cond, bar) do { unsigned _sp = 0; while (cond) { __builtin_amdgcn_s_sleep(1); \
    if ((++_sp & 255u) == 0u) { if (xb_ld(&(bar)[XB_TMO])) break; if (_sp > XB_SPIN_CAP) { atomicAdd(&(bar)[XB_TMO], 1u); break; } } } } while (0)
struct XcdBarrier { unsigned* bar; unsigned x; volatile LAS unsigned* st; };
__device__ __forceinline__ XcdBarrier xcd_barrier_post(unsigned* bar, volatile LAS unsigned* st) {
    XcdBarrier b; b.bar = bar; b.x = xb_xcc_id(); b.st = st;
    if (threadIdx.x == 0) (void)xb_add(&bar[XB_XCNT(b.x)], 1u);
    return b;
}
__device__ __forceinline__ void xcd_barrier_complete(unsigned* bar, unsigned x, unsigned& nloc, unsigned& nx) {
    const unsigned G = gridDim.x * gridDim.y * gridDim.z;
    unsigned sum, cnt, mine, sp = 0u;
    for (;;) {
        sum = 0u; cnt = 0u; mine = 0u;
#pragma unroll
        for (unsigned j = 0; j < 16; ++j) { const unsigned c = xb_ld(&bar[XB_XCNT(j)]); sum += c; cnt += (c > 0u) ? 1u : 0u; mine = (j == x) ? c : mine; }
        if (sum == G) break;
        __builtin_amdgcn_s_sleep(1);
        if ((++sp & 255u) == 0u) { if (xb_ld(&bar[XB_TMO])) break; if (sp > XB_SPIN_CAP) { atomicAdd(&bar[XB_TMO], 1u); break; } }
    }
    nloc = mine > 0u ? mine : 1u; nx = cnt > 0u ? cnt : 1u;
}
__device__ __forceinline__ void xcd_barrier(const XcdBarrier& b) {
    asm volatile("s_waitcnt vmcnt(0)" ::: "memory");
    __syncthreads();
    if (threadIdx.x == 0) {
        unsigned* bar = b.bar;
        __builtin_amdgcn_s_waitcnt(0);
        unsigned nloc = b.st[0], nx = b.st[1];
        if (nloc == 0u) { xcd_barrier_complete(bar, b.x, nloc, nx); b.st[0] = nloc; b.st[1] = nx; }
        const unsigned old = xb_add(&bar[XB_XSUB(b.x)], 1u);
        const unsigned gen = old / nloc;
        if (old + 1u == (gen + 1u) * nloc) {
            __builtin_amdgcn_fence(__ATOMIC_RELEASE, "agent");
            asm volatile("s_waitcnt vmcnt(0)" ::: "memory");
            const unsigned og = xb_add(&bar[XB_TOP], 1u);
            const unsigned tg = og / nx;
            if (og + 1u == (tg + 1u) * nx) xb_add(&bar[XB_TOPGEN], 1u);
            else XB_SPIN(xb_ld(&bar[XB_TOPGEN]) == tg, bar);
            __builtin_amdgcn_fence(__ATOMIC_ACQUIRE, "agent");
            xb_add(&bar[XB_XGEN(b.x)], 1u);
            asm volatile("s_waitcnt vmcnt(0)" ::: "memory");
        } else {
            XB_SPIN(xb_ld(&bar[XB_XGEN(b.x)]) == gen, bar);
            __builtin_amdgcn_fence(__ATOMIC_ACQUIRE, "agent");
            asm volatile("s_waitcnt vmcnt(0)" ::: "memory");
        }
    }
    __syncthreads();
}

#define WinT ((bf16_t*)(ws + O_WIN))
#define WguT ((bf16_t*)(ws + O_WGU))
#define WdnT ((bf16_t*)(ws + O_WDN))
#define WpaT ((bf16_t*)(ws + O_WPA))
#define WpbT ((bf16_t*)(ws + O_WPB))
#define WoutT ((bf16_t*)(ws + O_WOUT))
#define WpgT ((bf16_t*)(ws + O_WPG))
#define WpleT ((bf16_t*)(ws + O_WPLE))
#define WgrpT ((bf16_t*)(ws + O_WGRP))
#define h1 ((bf16_t*)(ws + O_H1))
#define merged h1
#define so ((bf16_t*)(ws + O_SO))
#define x2b so
#define ga ((bf16_t*)(ws + O_GA))
#define gb ((bf16_t*)(ws + O_GB))
#define numb ((bf16_t*)(ws + O_NUM))
#define tout numb
#define bm ((bf16_t*)(ws + O_BM))
#define h2 bm
#define T1 ((bf16_t*)(ws + O_T1))
#define fout T1
#define pe ((bf16_t*)(ws + O_PE))
#define vs_ ((bf16_t*)(ws + O_V))
#define ub ((bf16_t*)(ws + O_U))
#define qb ((bf16_t*)(ws + O_Q))
#define kb ((bf16_t*)(ws + O_K))
#define zb ((bf16_t*)(ws + O_Z))
#define ab ((bf16_t*)(ws + O_A))
#define vT ((bf16_t*)(ws + O_VT))
#define kwT ((bf16_t*)(ws + O_KWT))
#define pbf ((bf16_t*)(ws + O_PBF))
#define Sall ((bf16_t*)(ws + O_S))
#define act Sall
#define x1b ((bf16_t*)(ws + O_X1))
#define rs2b ((float*)(ws + O_SU))
#define igp ((float*)(ws + O_IG))
#define lfp ((float*)(ws + O_LF))
#define su ((float*)(ws + O_SU))
#define sw ((float*)(ws + O_SW))
#define sem ((float*)(ws + O_SEM))
#define swkf ((float*)(ws + O_SWKF))
#define denp ((float*)(ws + O_DENP))
#define ssq ((float*)(ws + O_SSQ))
#define part ((float*)(ws + O_PART))
#define flags ((unsigned*)(ws + O_FLAG))
#define barw ((unsigned*)(ws + O_BAR))
__global__ void __launch_bounds__(512, 2) mega(Params P) {
    extern __shared__ __attribute__((aligned(16))) unsigned char lds_raw[];
    LAS unsigned char* lds = (LAS unsigned char*)lds_raw;
    cg::grid_group grid = cg::this_grid();
    const int tid = threadIdx.x, lane = tid & 63, wid = __builtin_amdgcn_readfirstlane(tid >> 6), G = gridDim.x, bid = blockIdx.x;
    const int gw = bid * 8 + wid, NGW = G * 8, RPB = (T + G - 1) / G;
    unsigned char* ws = P.ws;

    if constexpr ((PHM >> 0) & 1)
    {
        LAS float* WgT = (LAS float*)lds;
        if (bid == 0) { for (int i = tid; i < 5 * 256 + 1; i += 512) flags[i * 16] = 0u; for (int i = tid; i < XCD_BAR_WORDS; i += 512) barw[i] = 0u; }
        if (tid < 4) ((volatile LAS unsigned*)(lds + LDS_BYTES - 16))[tid] = 0u;
        for (int k = tid; k < 2048; k += 512) { const f32x4 a = *(const f32x4*)(P.w_in + (size_t)k * NIN + 7168), b2 = *(const f32x4*)(P.w_in + (size_t)k * NIN + 7172);
            WgT[0 * 2048 + k] = a[0]; WgT[1 * 2048 + k] = a[1]; WgT[2 * 2048 + k] = a[2]; WgT[3 * 2048 + k] = a[3];
            WgT[4 * 2048 + k] = b2[0]; WgT[5 * 2048 + k] = b2[1]; WgT[6 * 2048 + k] = b2[2]; WgT[7 * 2048 + k] = b2[3]; }
        __syncthreads();
        for (int rk = wid; rk < RPB; rk += 8) { const int t = bid * RPB + rk; if (t >= T) break;

            const float* xr = (t < TP) ? P.x_prompt + (size_t)t * DM : P.x_sample + (size_t)(t - TP) * DM;
            f32x4 v[8]; float ss = 0.f;
#pragma unroll
            for (int j = 0; j < 8; ++j) { v[j] = ((const f32x4*)xr)[lane + 64 * j]; ss += v[j][0] * v[j][0] + v[j][1] * v[j][1] + v[j][2] * v[j][2] + v[j][3] * v[j][3]; }
            ss = wave_sum(ss); const float rstd = rsqrtf(ss * (1.f / DM) + EPS);
            u32x2* hr = (u32x2*)(h1 + (size_t)t * DM);
#pragma unroll
            for (int j = 0; j < 8; ++j) { const f32x4 g = ((const f32x4*)P.g_pre_mix)[lane + 64 * j]; v[j] = v[j] * rstd * g;
                u32x2 o; o.x = pk2(v[j][0], v[j][1]); o.y = pk2(v[j][2], v[j][3]); hr[lane + 64 * j] = o; }
            float gacc[8];
#pragma unroll
            for (int c = 0; c < 8; ++c) { float s = 0.f;
#pragma unroll
                for (int j = 0; j < 8; ++j) { const f32x4 w = *(const LAS f32x4*)(WgT + c * 2048 + 256 * j + 4 * lane); s += v[j][0] * w[0] + v[j][1] * w[1] + v[j][2] * w[2] + v[j][3] * w[3]; }
                gacc[c] = wave_sum(s); }
            if (lane == 0) {
#pragma unroll
                for (int hh = 0; hh < 4; ++hh) { igp[t * 4 + hh] = gacc[hh] + P.b_i[hh]; const float f = gacc[4 + hh] + P.b_f[hh];
                    lfp[t * 4 + hh] = fminf(f, 0.f) - log1pf(__expf(-fabsf(f))); } }
        }
        __syncthreads();
        LAS float* scr = (LAS float*)(lds + 65536) + wid * (64 * 33);
        for (int it = (7 - wid) * G + bid; it < 11264 + 1024 + (N_WITEMS - W_LATE1); it += NGW) {
            const int r = it < 11264 ? it : (it < 11264 + 1024 ? it - 11264 + (W_PB0 - 1024) : it - (11264 + 1024) + W_LATE1);
            weight_item(P, r, scr, lane); }
        for (int idx = bid * 512 + tid; idx < T * 32; idx += G * 512) { const int t = idx >> 5, c8 = (idx & 31) * 8;
            const float* pr = (t < TP) ? P.p_prompt + (size_t)t * PLE : P.p_sample + (size_t)(t - TP) * PLE;
            const f32x4 a = *(const f32x4*)(pr + c8), b2 = *(const f32x4*)(pr + c8 + 4);
            *(u32x4*)(pbf + (size_t)t * PLE + c8) = pack8(a, b2); }
    }
    grid.sync();
    const XcdBarrier xb = xcd_barrier_post(barw, (volatile LAS unsigned*)(lds + LDS_BYTES - 16));

    if constexpr ((PHM >> 1) & 1)
    {
        SchedP1 S1{G, bid, (const char*)h1, (const char*)WinT};
        EpiP1 E1{ub, qb, kb, vs_, so, ga, gb, vT};
        gemm_phase(lds, 2048, 2048, S1, E1);
        {
            const int rem = 1496 % G, nsl = rem ? G - rem : G, sl = rem ? bid - rem : bid;
            if (sl >= 0) { LAS float* scr = (LAS float*)lds + wid * (64 * 33);
                for (int it = W_LATE0 + sl * 8 + wid; it < W_LATE1; it += nsl * 8) weight_item(P, it, scr, lane); }
        }
        const int bh = bid - (G - 16);
        if (bh >= 0 && bh < 16 && wid == 0) {
            const int b = bh >> 2, h = bh & 3; float Bc = 0.f, Mc = 0.f;
            float lv[32], wv[32];
#pragma unroll
            for (int c = 0; c < 32; ++c) { const int t = b * 2048 + c * 64 + lane; lv[c] = lfp[t * 4 + h]; wv[c] = igp[t * 4 + h]; }
#pragma unroll
            for (int c = 0; c < 32; ++c) { const int s = c * 64 + lane;
                float cs = lv[c];
#pragma unroll
                for (int o = 1; o < 64; o <<= 1) { const float y = __shfl_up(cs, o); if (lane >= o) cs += y; }
                const float Bt = Bc + cs, w = wv[c] - Bt; float mx = w;
#pragma unroll
                for (int o = 1; o < 64; o <<= 1) { const float y = __shfl_up(mx, o); if (lane >= o) mx = fmaxf(mx, y); }
                mx = fmaxf(mx, Mc); wv[c] = w;
                su[bh * 2048 + s] = -mx * LOG2E; sw[bh * 2048 + s] = w * LOG2E; sem[bh * 2048 + s] = __expf(-(Bt + mx));
                Bc = __shfl(Bt, 63); Mc = __shfl(mx, 63); }
#pragma unroll
            for (int c = 0; c < 32; ++c) { const int s = c * 64 + lane; swkf[bh * 2048 + s] = __builtin_amdgcn_exp2f((wv[c] - Mc) * LOG2E); }
            if (lane == 0) P.out[OUT_MP + bh] = Bc + Mc;
        }
    }
    xcd_barrier(xb);

    if constexpr ((PHM >> 2) & 1)
    {
        SchedQK S1{G, bid, (const char*)qb, (const char*)kb};
        EpiS E1{Sall, su, sw, denp};
        if constexpr (P2M & 1) gemm_phase(lds, 1024, 1024, S1, E1);
        if constexpr (P2M & 2)
        for (int idx = bid * 512 + tid; idx < T * 128; idx += G * 512) {
            const int t = idx >> 7, ch0 = (idx & 127) * 8, g = ch0 >> 8;
            if (g == 0) pool_z_item<2>(P, ub, zb, t, ch0); else if (g == 1) pool_z_item<4>(P, ub, zb, t, ch0);
            else if (g == 2) pool_z_item<8>(P, ub, zb, t, ch0); else pool_z_item<16>(P, ub, zb, t, ch0);
        }
        for (int idx = bid * 512 + tid; idx < 4 * 15 * 128; idx += G * 512) { const int c8 = (idx & 127) * 8, r = (idx >> 7) % 15, b = idx / (15 * 128);
            const u32x4 v = *(const u32x4*)(ub + (size_t)(b * 2048 + 2033 + r) * 1024 + c8); float* o = P.out + OUT_POOLP + ((size_t)b * 15 + r) * 1024 + c8;
            *(f32x4*)o = unlo(v); *(f32x4*)(o + 4) = unhi(v); }
        for (int idx = bid * 512 + tid; idx < 128 * 15 * 128; idx += G * 512) { const int c8 = (idx & 127) * 8, r = (idx >> 7) % 15, b = idx / (15 * 128);
            float* o = P.out + OUT_POOLS + ((size_t)b * 15 + r) * 1024 + c8;
            if (r < 11) { const float* sp = P.state_pool + ((size_t)b * 15 + r + 4) * 1024 + c8; *(f32x4*)o = *(const f32x4*)sp; *(f32x4*)(o + 4) = *(const f32x4*)(sp + 4); }
            else { const u32x4 v = *(const u32x4*)(ub + (size_t)(TP + b * 4 + (r - 11)) * 1024 + c8); *(f32x4*)o = unlo(v); *(f32x4*)(o + 4) = unhi(v); } }
        if constexpr (P2M & 4) {
            LAS float* scr = (LAS float*)lds + wid * (64 * 33);
            for (int it = gw; it < 128 * 32; it += NGW) { const int tb = it >> 5, db = it & 31, tok0 = tb * 64, d0 = db * 32, b = tok0 >> 11, h = d0 >> 8, bh = b * 4 + h;
#pragma unroll
                for (int i = 0; i < 4; ++i) { const int r = i * 16 + (lane >> 2); const u32x4 raw = *(const u32x4*)(kb + (size_t)(tok0 + r) * 1024 + d0 + (lane & 3) * 8);
                    const float wv = swkf[bh * 2048 + (tok0 & 2047) + r]; LAS float* s = scr + r * 33 + (lane & 3) * 8; const f32x4 a = unlo(raw) * wv, b2 = unhi(raw) * wv;
                    s[0] = a[0]; s[1] = a[1]; s[2] = a[2]; s[3] = a[3]; s[4] = b2[0]; s[5] = b2[1]; s[6] = b2[2]; s[7] = b2[3]; }
                LDS_WAIT();
                const int c = lane & 7;
#pragma unroll
                for (int j = 0; j < 4; ++j) { const int d = (lane >> 3) + 8 * j; const LAS float* s = scr + (8 * c) * 33 + d;
                    u32x4 o; o.x = pk2(s[0 * 33], s[1 * 33]); o.y = pk2(s[2 * 33], s[3 * 33]); o.z = pk2(s[4 * 33], s[5 * 33]); o.w = pk2(s[6 * 33], s[7 * 33]);
                    *(u32x4*)(kwT + (size_t)(d0 + d) * TP + tok0 + 8 * c) = o; }
                LDS_WAIT();
            }
            {
                const int rem = 576 % G, nsl = rem ? G - rem : G, sl = rem ? bid - rem : bid;
                if (sl >= 0) for (int it = 16896 + sl * 8 + wid; it < 16896 + 5632; it += nsl * 8) weight_item(P, it, scr, lane);
            }
        }
        __syncthreads();
    }
    xcd_barrier(xb);

    if constexpr ((PHM >> 3) & 1)
    {
        SchedSV S1{G, bid, (const char*)Sall, (const char*)vT, (const char*)kwT};
        EpiSV E1{numb, P.out + OUT_CP};
        gemm_phase(lds, 8192, 8192, S1, E1);
        SchedPool S2{G, bid, (const char*)zb, (const char*)WgrpT};
        EpiPool E2{ab, P.s_pool};
        gemm_phase(lds, 1024, 256, S2, E2);
        __syncthreads();
        {
            volatile LAS int* qslot = (volatile LAS int*)(lds + LDS_BYTES - 32);
            for (;;) {
                if (tid == 0) *qslot = (int)__hip_atomic_fetch_add(flags + 5 * 4096, 1u, __ATOMIC_RELAXED, __HIP_MEMORY_SCOPE_AGENT);
                __syncthreads();
                const int item = *qslot;
                __syncthreads();
                if (item >= 512) break;
                sample_item(P, item, (LAS float*)lds);
            }
        }
        for (int r = gw; r < 16 * 256; r += NGW) { const int bh = r >> 8, d = r & 255, b = bh >> 2, h = bh & 3; float s = 0.f;
            const bf16_t* kr = kwT + (size_t)(h * 256 + d) * TP + b * 2048;
#pragma unroll
            for (int j = 0; j < 4; ++j) { const u32x4 w = *(const u32x4*)(kr + (lane + 64 * j) * 8); const f32x4 a = unlo(w), b2 = unhi(w); s += a[0] + a[1] + a[2] + a[3] + b2[0] + b2[1] + b2[2] + b2[3]; }
            s = wave_sum(s); if (lane == 0) P.out[OUT_NP + r] = s; }
    }
    xcd_barrier(xb);

    if constexpr ((PHM >> 4) & 1)
    {
        for (int rk = wid; rk < RPB; rk += 8) { const int t = bid * RPB + rk; if (t >= T) break;
            u32x4 raw[4], sr[4]; float dsum[4], emv[4];
#pragma unroll
            for (int h = 0; h < 4; ++h) { raw[h] = *(const u32x4*)(numb + (size_t)t * 2048 + h * 512 + lane * 8); sr[h] = *(const u32x4*)(so + (size_t)t * 2048 + h * 512 + lane * 8); dsum[h] = 0.f; emv[h] = 1.f; }
            if (t < TP) { const int b = t >> 11, s = t & 2047, cnt = 4 * ((s >> 8) + 1);
#pragma unroll
                for (int h = 0; h < 4; ++h) { const int bh = b * 4 + h; dsum[h] = (lane < cnt) ? denp[(size_t)(bh * 2048 + s) * 32 + lane] : 0.f; emv[h] = sem[bh * 2048 + s]; }
#pragma unroll
                for (int o = 1; o < 64; o <<= 1) {
#pragma unroll
                    for (int h = 0; h < 4; ++h) dsum[h] += __shfl_xor(dsum[h], o); }
            }
            f32x4 a[4], b2[4]; float ss[4];
#pragma unroll
            for (int h = 0; h < 4; ++h) { a[h] = unlo(raw[h]); b2[h] = unhi(raw[h]);
                if (t < TP) { const float dd = 1.f / fmaxf(fabsf(dsum[h]), emv[h]); a[h] = a[h] * dd; b2[h] = b2[h] * dd; }
                ss[h] = a[h][0] * a[h][0] + a[h][1] * a[h][1] + a[h][2] * a[h][2] + a[h][3] * a[h][3] + b2[h][0] * b2[h][0] + b2[h][1] * b2[h][1] + b2[h][2] * b2[h][2] + b2[h][3] * b2[h][3]; }
#pragma unroll
            for (int o = 1; o < 64; o <<= 1) {
#pragma unroll
                for (int h = 0; h < 4; ++h) ss[h] += __shfl_xor(ss[h], o); }
#pragma unroll
            for (int h = 0; h < 4; ++h) { const float rstd = rsqrtf(ss[h] * (1.f / 512.f) + EPS);
                const f32x4 g0 = *(const f32x4*)(P.g_head + h * 512 + lane * 8), g1 = *(const f32x4*)(P.g_head + h * 512 + lane * 8 + 4);
                *(u32x4*)(bm + (size_t)t * 2048 + h * 512 + lane * 8) = pack8(a[h] * rstd * g0 * unlo(sr[h]), b2[h] * rstd * g1 * unhi(sr[h])); }
        }
        __syncthreads();
        SchedU S1; S1.init(G, bid, ab, 1024, WpaT, 1024, 34, 8, 1024);
        EpiPA E1{T1, ga};
        gemm_phase(lds, 1024, 1024, S1, E1);
        SchedPe S2{G, bid, (const char*)pbf, (const char*)WpleT};
        EpiBf E2{pe, 2048};
        gemm_phase(lds, PLE, PLE, S2, E2);
        {
            const int skip = (272 - G > 0 && 272 - G < G) ? 272 - G : 0;
            if (bid >= skip) { LAS float* scr = (LAS float*)lds + wid * (64 * 33);
                for (int it = W_PB0 + (bid - skip) * 8 + wid; it < W_PB0 + 2048; it += (G - skip) * 8) weight_item(P, it, scr, lane);
                for (int it = 11264 + (bid - skip) * 8 + wid; it < 11264 + 5632; it += (G - skip) * 8) weight_item(P, it, scr, lane); }
        }
    }
    xcd_barrier(xb);

    if constexpr ((PHM >> 5) & 1)
    {
        SchedK S1; S1.init(G, bid, bm, 2048, WpbT, 2048, 34, 8, 2048);
        EpiPB E1{merged, T1, gb};
        gemm_phase(lds, 2048, 2048, S1, E1, part, flags + 1 * 4096, 8u * (REPI + 1));
    }
    xcd_barrier(xb);

    if constexpr ((PHM >> 6) & 1)
    {
        SchedK S1; S1.init(G, bid, merged, 2048, WoutT, 2048, 34, 8, 2048);
        EpiSq E1{tout, ssq};
        gemm_phase(lds, 2048, 2048, S1, E1, part, flags + 2 * 4096, 8u * (REPI + 1));
    }
    xcd_barrier(xb);

    if constexpr ((PHM >> 7) & 1)
    {
        for (int rk = wid; rk < RPB; rk += 8) { const int t = bid * RPB + rk; if (t >= T) break;

            const float* xr = (t < TP) ? P.x_prompt + (size_t)t * DM : P.x_sample + (size_t)(t - TP) * DM;
            float q = (lane < 32) ? ssq[(size_t)t * 32 + lane] : 0.f; q = wave_sum(q); const float rs1 = rsqrtf(q * (1.f / DM) + EPS);
            f32x4 xa[4], xb[4]; float ss = 0.f;
#pragma unroll
            for (int j = 0; j < 4; ++j) { const int c = lane * 8 + 512 * j; const u32x4 raw = *(const u32x4*)(tout + (size_t)t * DM + c);
                const f32x4 g0 = *(const f32x4*)(P.g_post_mix + c), g1 = *(const f32x4*)(P.g_post_mix + c + 4);
                xa[j] = *(const f32x4*)(xr + c) + unlo(raw) * rs1 * g0; xb[j] = *(const f32x4*)(xr + c + 4) + unhi(raw) * rs1 * g1;
                *(u32x4*)(x1b + (size_t)t * DM + c) = pack8(xa[j], xb[j]);
                ss += xa[j][0] * xa[j][0] + xa[j][1] * xa[j][1] + xa[j][2] * xa[j][2] + xa[j][3] * xa[j][3] + xb[j][0] * xb[j][0] + xb[j][1] * xb[j][1] + xb[j][2] * xb[j][2] + xb[j][3] * xb[j][3]; }
            ss = wave_sum(ss); if (lane == 0) rs2b[t] = rsqrtf(ss * (1.f / DM) + EPS);
        }
    }
    xcd_barrier(xb);

    if constexpr ((PHM >> 8) & 1)
    {
        SchedU S1; S1.init(G, bid, x1b, 2048, WguT, 2048, 34, 44, 2048);
        EpiSwi E1{act, rs2b};
        gemm_phase(lds, 2048, 2048, S1, E1);
        {
            const int rem = 1496 % G, nsl = rem ? G - rem : G, sl = rem ? bid - rem : bid;
            if (sl >= 0) { LAS float* scr = (LAS float*)lds + wid * (64 * 33);
                for (int it = W_DN0 + sl * 8 + wid; it < W_DN0 + 5632; it += nsl * 8) weight_item(P, it, scr, lane); }
        }
    }
    xcd_barrier(xb);

    if constexpr ((PHM >> 9) & 1)
    {
        SchedK S1; S1.init(G, bid, act, DFF, WdnT, DFF, 34, 8, DFF);
        EpiSq E1{fout, ssq};
        gemm_phase(lds, DFF, DFF, S1, E1, part, flags + 3 * 4096, 8u * (REPI + 1));
    }
    xcd_barrier(xb);

    if constexpr ((PHM >> 10) & 1)
    {
        for (int rk = wid; rk < RPB; rk += 8) { const int t = bid * RPB + rk; if (t >= T) break;

            float q = (lane < 32) ? ssq[(size_t)t * 32 + lane] : 0.f; q = wave_sum(q); const float rs1 = rsqrtf(q * (1.f / DM) + EPS);
#pragma unroll
            for (int j = 0; j < 4; ++j) { const int c = lane * 8 + 512 * j; const u32x4 raw = *(const u32x4*)(fout + (size_t)t * DM + c);
                const f32x4 g0 = *(const f32x4*)(P.g_post_ffn + c), g1 = *(const f32x4*)(P.g_post_ffn + c + 4);
                const u32x4 xr1 = *(const u32x4*)(x1b + (size_t)t * DM + c);
                const f32x4 a = unlo(xr1) + unlo(raw) * rs1 * g0, b2 = unhi(xr1) + unhi(raw) * rs1 * g1;
                *(u32x4*)(x2b + (size_t)t * DM + c) = pack8(a, b2); }
        }
    }
    xcd_barrier(xb);

    if constexpr ((PHM >> 11) & 1)
    {
        SchedK S1; S1.init(G, bid, x2b, 2048, WpgT, 2048, 34, 8, 2048);
        EpiPle E1{P.out, x2b, pe};
        gemm_phase(lds, 2048, 2048, S1, E1, part, flags + 4 * 4096, 8u * (REPI + 1));
    }
}

#undef WinT
#undef WguT
#undef WdnT
#undef WpaT
#undef WpbT
#undef WoutT
#undef WpgT
#undef WpleT
#undef WgrpT
#undef h1
#undef merged
#undef so
#undef x2b
#undef ga
#undef gb
#undef numb
#undef tout
#undef bm
#undef h2
#undef T1
#undef fout
#undef pe
#undef vs_
#undef ub
#undef qb
#undef kb
#undef zb
#undef ab
#undef vT
#undef kwT
#undef pbf
#undef Sall
#undef act
#undef x1b
#undef rs2b
#undef igp
#undef lfp
#undef su
#undef sw
#undef sem
#undef swkf
#undef denp
#undef ssq
#undef part
#undef flags
#undef barw

extern "C" void kernel_launch(void* const* d_in, const int* in_sizes, int n_in, void* d_out, int out_size, void* d_ws, size_t ws_size, hipStream_t stream) {
    static int grid = 0;
    if (grid == 0) {
        if (n_in != 26 || ws_size < O_END) { fprintf(stderr, "kernel_launch: unexpected n_in %d or workspace %zu < %zu\n", n_in, ws_size, (size_t)O_END); grid = -1; return; }
        int dev = 0, cus = 0, per_cu = 0;
        (void)hipGetDevice(&dev);
        (void)hipDeviceGetAttribute(&cus, hipDeviceAttributeMultiprocessorCount, dev);
        if (hipFuncSetAttribute((const void*)mega, hipFuncAttributeMaxDynamicSharedMemorySize, LDS_BYTES) != hipSuccess) { fprintf(stderr, "kernel_launch: hipFuncSetAttribute failed\n"); grid = -1; return; }
        if (hipOccupancyMaxActiveBlocksPerMultiprocessor(&per_cu, (const void*)mega, 512, LDS_BYTES) != hipSuccess || per_cu < 1) { fprintf(stderr, "kernel_launch: occupancy query gave %d\n", per_cu); per_cu = 1; }
        (void)hipGetLastError();
        grid = cus * 1;
        if (grid > 256) grid = 256;
    }
    if (grid < 0) return;
    Params p{};
    const float** pp = (const float**)&p;
    for (int i = 0; i < 26; ++i) pp[i] = (const float*)d_in[i];
    p.out = (float*)d_out; p.ws = (unsigned char*)d_ws;
    void* args[] = {&p};
    hipError_t e = hipLaunchCooperativeKernel((const void*)mega, dim3(grid), dim3(512), args, LDS_BYTES, stream);
    if (e != hipSuccess) fprintf(stderr, "cooperative launch failed: %s (grid %d)\n", hipGetErrorString(e), grid);
}
```

```cpp
#include <hip/hip_runtime.h>
#include <hip/hip_cooperative_groups.h>
#include <cstdio>
namespace cg = cooperative_groups;

#define LAS __attribute__((address_space(3)))
typedef unsigned short bf16_t;
typedef short bf16x8 __attribute__((ext_vector_type(8)));
typedef float f32x4 __attribute__((ext_vector_type(4)));
typedef unsigned u32x4 __attribute__((ext_vector_type(4)));
typedef unsigned u32x2 __attribute__((ext_vector_type(2)));

constexpr int T = 8704, TP = 8192, TS = 512, DM = 2048, NIN = 11272, NP = 11264, DP = 1024, HQK = 1024, HV = 2048, DFF = 5632, PLE = 256;
constexpr float EPS = 1e-6f, LOG2E = 1.4426950408889634f;
constexpr size_t OUT_YS = (size_t)TP * DM, OUT_POOLP = OUT_YS + (size_t)TS * DM, OUT_CP = OUT_POOLP + 4 * 15 * 1024,
                 OUT_NP = OUT_CP + (size_t)16 * 256 * 512, OUT_MP = OUT_NP + 16 * 256, OUT_POOLS = OUT_MP + 16,
                 OUT_CS = OUT_POOLS + (size_t)128 * 15 * 1024, OUT_NS = OUT_CS + (size_t)512 * 256 * 512, OUT_MS = OUT_NS + 512 * 256;
constexpr size_t O_WIN = 0;
constexpr size_t O_WGU = O_WIN + (size_t)NP * DM * 2;
constexpr size_t O_WDN = O_WGU + (size_t)NP * DM * 2;
constexpr size_t O_WPA = O_WDN + (size_t)DM * DFF * 2;
constexpr size_t O_WPB = O_WPA + (size_t)DM * DP * 2;
constexpr size_t O_WOUT = O_WPB + (size_t)DM * DM * 2;
constexpr size_t O_WPG = O_WOUT + (size_t)DM * DM * 2;
constexpr size_t O_WPLE = O_WPG + (size_t)DM * DM * 2;
constexpr size_t O_WGRP = O_WPLE + (size_t)DM * PLE * 2;
constexpr size_t O_H1 = O_WGRP + (size_t)DP * 256 * 2;
constexpr size_t O_SO = O_H1 + (size_t)T * DM * 2;
constexpr size_t O_GA = O_SO + (size_t)T * DM * 2;
constexpr size_t O_GB = O_GA + (size_t)T * DM * 2;
constexpr size_t O_NUM = O_GB + (size_t)T * DM * 2;
constexpr size_t O_BM = O_NUM + (size_t)T * DM * 2;
constexpr size_t O_T1 = O_BM + (size_t)T * DM * 2;
constexpr size_t O_PE = O_T1 + (size_t)T * DM * 2;
constexpr size_t O_V = O_PE + (size_t)T * DM * 2;
constexpr size_t O_U = O_V + (size_t)TS * HV * 2;
constexpr size_t O_Q = O_U + (size_t)T * 1024 * 2;
constexpr size_t O_K = O_Q + (size_t)T * 1024 * 2;
constexpr size_t O_Z = O_K + (size_t)T * 1024 * 2;
constexpr size_t O_A = O_Z + (size_t)T * 1024 * 2;
constexpr size_t O_VT = O_A + (size_t)T * 1024 * 2;
constexpr size_t O_KWT = O_VT + (size_t)HV * TP * 2;
constexpr size_t O_PBF = O_KWT + (size_t)HQK * TP * 2;
constexpr size_t O_S = O_PBF + (size_t)T * PLE * 2;
constexpr size_t O_X1 = O_S + (size_t)TP * 8192 * 2;
constexpr size_t O_IG = O_X1 + (size_t)T * DM * 4;
constexpr size_t O_LF = O_IG + (size_t)T * 4 * 4;
constexpr size_t O_SU = O_LF + (size_t)T * 4 * 4;
constexpr size_t O_SW = O_SU + 16 * 2048 * 4;
constexpr size_t O_SEM = O_SW + 16 * 2048 * 4;
constexpr size_t O_SWKF = O_SEM + 16 * 2048 * 4;
constexpr size_t O_DENP = O_SWKF + 16 * 2048 * 4;
constexpr size_t O_SSQ = O_DENP + (size_t)16 * 2048 * 32 * 4;
constexpr size_t O_FLAG = O_SSQ + (size_t)T * 32 * 4;
constexpr size_t O_BAR = O_FLAG + 1024 * 64 * 4;
constexpr size_t O_PART = O_BAR + 16384;
constexpr size_t O_END = O_PART + (size_t)256 * 32 * 512 * 16;
static_assert((size_t)T * DFF * 2 <= (size_t)TP * 8192 * 2, "act alias");

constexpr int LDS_BYTES = 147456;
#ifndef REP_PHASE
#define REP_PHASE -1
#define REP_N 1
#define REPI 0
#endif
#ifndef P2M
#define P2M 15
#endif
#ifndef PHM
#define PHM 0xFFF
#endif

struct Params {
    const float *x_prompt, *x_sample, *p_prompt, *p_sample, *state_pool, *state_C, *state_n, *state_m, *g_pre_mix, *w_in, *b_i, *b_f,
        *w_pool_grp, *s_pool, *g_head, *w_pa, *w_pb, *w_out, *g_post_mix, *g_pre_ffn, *w_gate, *w_up, *w_down, *g_post_ffn, *w_ple, *w_ple_gate;
    float* out;
    unsigned char* ws;
};

__device__ __forceinline__ unsigned pk2(float lo, float hi) { unsigned r; asm("v_cvt_pk_bf16_f32 %0, %1, %2" : "=v"(r) : "v"(lo), "v"(hi)); return r; }
__device__ __forceinline__ float bflo(unsigned w) { return __uint_as_float(w << 16); }
__device__ __forceinline__ float bfhi(unsigned w) { return __uint_as_float(w & 0xffff0000u); }
__device__ __forceinline__ float bf1(bf16_t v) { return __uint_as_float(((unsigned)v) << 16); }
__device__ __forceinline__ float wave_sum(float v) {
#pragma unroll
    for (int o = 1; o < 64; o <<= 1) v += __shfl_xor(v, o);
    return v;
}
__device__ __forceinline__ float fsigmoid(float x) { return __builtin_amdgcn_rcpf(1.0f + __builtin_amdgcn_exp2f(-x * LOG2E)); }
__device__ __forceinline__ u32x4 pack8(const f32x4 v0, const f32x4 v1) { u32x4 w; w.x = pk2(v0[0], v0[1]); w.y = pk2(v0[2], v0[3]); w.z = pk2(v1[0], v1[1]); w.w = pk2(v1[2], v1[3]); return w; }
__device__ __forceinline__ f32x4 unlo(const u32x4 w) { return (f32x4){bflo(w.x), bfhi(w.x), bflo(w.y), bfhi(w.y)}; }
__device__ __forceinline__ f32x4 unhi(const u32x4 w) { return (f32x4){bflo(w.z), bfhi(w.z), bflo(w.w), bfhi(w.w)}; }
__device__ __forceinline__ f32x4 sig4(f32x4 v) { return (f32x4){fsigmoid(v[0]), fsigmoid(v[1]), fsigmoid(v[2]), fsigmoid(v[3])}; }
#define LDS_WAIT() asm volatile("s_waitcnt lgkmcnt(0)" ::: "memory")

constexpr int BK = 64, HALF = 128, HTB = HALF * BK * 2;
__device__ __forceinline__ int lds_byte(int r, int c) { const int st = (r >> 4) * 2 + (c >> 5), rr = r & 15, cc = c & 31, ob = rr * 64 + cc * 2; return st * 1024 + (ob ^ (((ob >> 9) & 1) << 5)); }
__device__ __forceinline__ void stage_rc(int b, int& R, int& C) { const int st = b / 1024, sb = b % 1024, swz = sb ^ (((sb >> 9) & 1) << 5); R = (st >> 1) * 16 + swz / 64; C = (st & 1) * 32 + (swz % 64) / 2; }
__device__ __forceinline__ int perm32(int rho) { const int n = rho >> 4, i = rho & 15; return 8 * (i >> 2) + 4 * n + (i & 3); }

struct Unit { const char* A; const char* B; int nt, pm, pn, z, mode, slot; };

__device__ __forceinline__ int xcd_remap(int L, int nwg) { const int q = nwg / 8, r = nwg % 8, xcd = L % 8, off = L / 8; return (xcd < r ? xcd * (q + 1) : r * (q + 1) + (xcd - r) * q) + off; }
__device__ __forceinline__ void grouped(int w, int nM, int nN, int& pm, int& pn) { const int nig = 8 * nN, gid = w / nig, fm = gid * 8, gsz = (nM - fm) < 8 ? (nM - fm) : 8; pm = fm + ((w % nig) % gsz); pn = (w % nig) / gsz; }

template <class Sched, class Epi>
__device__ __forceinline__ void gemm_phase(LAS unsigned char* lds, const int lda, const int ldb, const Sched& S, const Epi& E, float* part = nullptr, unsigned* flags = nullptr, unsigned target = 0u) {
    const int tid = threadIdx.x, wid = __builtin_amdgcn_readfirstlane(tid >> 6), lane = tid & 63, wr = wid >> 2, wc = wid & 3, fr = lane & 15, fq = lane >> 4;
    unsigned voffA[2], voffB[2];
#pragma unroll
    for (int i = 0; i < 2; ++i) { int R, C; stage_rc(tid * 16 + i * 8192, R, C); const int Rb = (R & ~31) + perm32(R & 31);
        voffA[i] = (unsigned)(R * lda + C) * 2u; voffB[i] = (unsigned)(Rb * ldb + C) * 2u; }
    const size_t kstep = (size_t)(BK * 2);
    const size_t hstepA = (size_t)HALF * lda * 2, hstepB = (size_t)HALF * ldb * 2;
    const unsigned ldsw = (unsigned)wid * 1024u;
    const int aoff = lds_byte(wr * 64 + fr, fq * 8), boff = lds_byte(wc * 32 + fr, fq * 8);
#define PG8_SA(b, h) (((b) * 2 + (h)) * HTB)
#define PG8_SB(b, h) ((4 + (b) * 2 + (h)) * HTB)
#define PG8_STAGE(bufoff, gbase, voff) do { _Pragma("unroll") for (int _i = 0; _i < 2; ++_i) \
        __builtin_amdgcn_global_load_lds((const unsigned*)((const char*)(gbase) + (voff)[_i]), (LAS unsigned*)(lds + (bufoff) + ldsw + _i * 8192), 16, 0, 0); } while (0)
#define PG8_LDA(dst, b, h) do { _Pragma("unroll") for (int m = 0; m < 4; ++m) _Pragma("unroll") for (int k = 0; k < 2; ++k) dst[m][k] = *(const LAS bf16x8*)(lds + PG8_SA(b, h) + aoff + m * 2048 + k * 1024); } while (0)
#define PG8_LDB(dst, b, h) do { _Pragma("unroll") for (int n = 0; n < 2; ++n) _Pragma("unroll") for (int k = 0; k < 2; ++k) dst[n][k] = *(const LAS bf16x8*)(lds + PG8_SB(b, h) + boff + n * 2048 + k * 1024); } while (0)
#define PG8_MMA(ai, bj, At, Bt) do { __builtin_amdgcn_s_setprio(1); _Pragma("unroll") for (int m = 0; m < 4; ++m) _Pragma("unroll") for (int n = 0; n < 2; ++n) _Pragma("unroll") for (int k = 0; k < 2; ++k) \
        acc[ai][bj][m][n] = __builtin_amdgcn_mfma_f32_16x16x32_bf16(Bt[n][k], At[m][k], acc[ai][bj][m][n], 0, 0, 0); __builtin_amdgcn_s_setprio(0); } while (0)
#define PG8_WAIT_V(n) asm volatile("s_waitcnt vmcnt(" #n ")" ::: "memory")
#define PG8_WAIT_L(n) asm volatile("s_waitcnt lgkmcnt(" #n ")" ::: "memory")
#define PG8_BAR __builtin_amdgcn_s_barrier()
#define PG8_SCHED __builtin_amdgcn_sched_barrier(0)
    Unit cur, nxt; int ui = 0;
    if (!S.next(0, cur)) return;
    f32x4 acc[2][2][4][2];
#pragma unroll
    for (int a = 0; a < 2; ++a)
#pragma unroll
        for (int b = 0; b < 2; ++b)
#pragma unroll
            for (int m = 0; m < 4; ++m)
#pragma unroll
                for (int n = 0; n < 2; ++n) acc[a][b][m][n] = (f32x4){0.f, 0.f, 0.f, 0.f};
    bf16x8 At[4][2], B0[2][2], B1[2][2];
    const char* cA = cur.A; const char* cB = cur.B;
    PG8_STAGE(PG8_SB(0, 0), cB, voffB); PG8_STAGE(PG8_SA(0, 0), cA, voffA); PG8_STAGE(PG8_SB(0, 1), cB + hstepB, voffB); PG8_STAGE(PG8_SA(0, 1), cA + hstepA, voffA);
    if (wr == 1) PG8_BAR;
    PG8_WAIT_V(4); PG8_BAR;
    PG8_STAGE(PG8_SB(1, 0), cB + kstep, voffB); PG8_STAGE(PG8_SA(1, 0), cA + kstep, voffA); PG8_STAGE(PG8_SB(1, 1), cB + hstepB + kstep, voffB);
    PG8_WAIT_V(6); PG8_BAR;
    for (;;) {
        const bool has_next = S.next(ui + 1, nxt);
        const char* nA = has_next ? nxt.A : cA; const char* nB = has_next ? nxt.B : cB;
        int nt = cur.nt; asm volatile("" : "+s"(nt));
        for (int t = 0; t < nt; t += 2) {
            const bool last = (t == nt - 2);
            const char* a1 = cA + (size_t)(t + 1) * kstep;
            const char* a2 = last ? nA : cA + (size_t)(t + 2) * kstep; const char* b2 = last ? nB : cB + (size_t)(t + 2) * kstep;
            asm volatile("" : "+s"(a1), "+s"(a2), "+s"(b2));
            const char* a3 = a2 + kstep; const char* b3 = b2 + kstep;
            PG8_LDB(B0, 0, 0); PG8_SCHED; PG8_LDA(At, 0, 0); PG8_STAGE(PG8_SA(1, 1), a1 + hstepA, voffA);
            PG8_WAIT_L(8); PG8_BAR; PG8_WAIT_L(0); PG8_MMA(0, 0, At, B0); PG8_BAR; PG8_SCHED;
            PG8_LDB(B1, 0, 1); PG8_STAGE(PG8_SB(0, 0), b2, voffB);
            PG8_BAR; PG8_WAIT_L(0); PG8_MMA(0, 1, At, B1); PG8_BAR;
            PG8_LDA(At, 0, 1); PG8_STAGE(PG8_SA(0, 0), a2, voffA);
            PG8_BAR; PG8_WAIT_L(0); PG8_MMA(1, 0, At, B0); PG8_BAR; PG8_SCHED;
            PG8_STAGE(PG8_SB(0, 1), b2 + hstepB, voffB);
            PG8_WAIT_V(6); PG8_BAR; PG8_MMA(1, 1, At, B1); PG8_BAR;
            PG8_LDB(B0, 1, 0); PG8_SCHED; PG8_LDA(At, 1, 0); PG8_STAGE(PG8_SA(0, 1), a2 + hstepA, voffA);
            PG8_WAIT_L(8); PG8_BAR; PG8_WAIT_L(0); PG8_MMA(0, 0, At, B0); PG8_BAR; PG8_SCHED;
            PG8_LDB(B1, 1, 1); PG8_STAGE(PG8_SB(1, 0), b3, voffB);
            PG8_BAR; PG8_WAIT_L(0); PG8_MMA(0, 1, At, B1); PG8_BAR;
            PG8_LDA(At, 1, 1); PG8_STAGE(PG8_SA(1, 0), a3, voffA);
            PG8_BAR; PG8_WAIT_L(0); PG8_MMA(1, 0, At, B0); PG8_BAR; PG8_SCHED;
            PG8_STAGE(PG8_SB(1, 1), b3 + hstepB, voffB);
            PG8_WAIT_V(6); PG8_BAR; PG8_MMA(1, 1, At, B1); PG8_BAR;
        }
        if constexpr (Sched::SK) {
            if (cur.mode == 2) {
                while (__hip_atomic_load(flags + cur.slot * 16, __ATOMIC_RELAXED, __HIP_MEMORY_SCOPE_AGENT) < target) __builtin_amdgcn_s_sleep(2);
                const __amdgpu_buffer_rsrc_t rl_ = __builtin_amdgcn_make_buffer_rsrc((void*)((char*)part + (size_t)cur.slot * 131072), (short)0, 131072, 0x00020000);
#pragma unroll
                for (int a = 0; a < 2; ++a) {
                    u32x4 tmp[8];
#pragma unroll
                    for (int j = 0; j < 8; ++j) tmp[j] = __builtin_amdgcn_raw_buffer_load_b128(rl_, tid * 16, (a * 8 + j) * 8192, 16);
                    asm volatile("s_waitcnt vmcnt(0)" ::: "memory");
#pragma unroll
                    for (int j = 0; j < 8; ++j) { acc[a][j >> 2][j & 3][0] += unlo(tmp[j]); acc[a][j >> 2][j & 3][1] += unhi(tmp[j]); }
                    __builtin_amdgcn_sched_barrier(0);
                }
            }
            __builtin_amdgcn_sched_barrier(0);
            if (cur.mode == 1) {
                const __amdgpu_buffer_rsrc_t rs = __builtin_amdgcn_make_buffer_rsrc((void*)((char*)part + (size_t)cur.slot * 131072), (short)0, 131072, 0x00020000);
#pragma unroll
                for (int a = 0; a < 2; ++a)
#pragma unroll
                    for (int b = 0; b < 2; ++b)
#pragma unroll
                        for (int m = 0; m < 4; ++m)
                            __builtin_amdgcn_raw_buffer_store_b128(pack8(acc[a][b][m][0], acc[a][b][m][1]), rs, tid * 16, ((a * 2 + b) * 4 + m) * 8192, 16);
                asm volatile("s_waitcnt vmcnt(0)" ::: "memory");
                if (lane == 0) __hip_atomic_fetch_add(flags + cur.slot * 16, 1u, __ATOMIC_RELAXED, __HIP_MEMORY_SCOPE_AGENT);
            } else {
                E(acc, cur, wr, wc, fr, fq);
            }
        } else {
            E(acc, cur, wr, wc, fr, fq);
        }
        if (!has_next) break;
#pragma unroll
        for (int a = 0; a < 2; ++a)
#pragma unroll
            for (int b = 0; b < 2; ++b)
#pragma unroll
                for (int m = 0; m < 4; ++m)
#pragma unroll
                    for (int n = 0; n < 2; ++n) acc[a][b][m][n] = (f32x4){0.f, 0.f, 0.f, 0.f};
        cur = nxt; cA = nA; cB = nB; ++ui;
    }
    PG8_WAIT_V(0);
    if (wr == 0) PG8_BAR;
    PG8_BAR;
#undef PG8_SA
#undef PG8_SB
#undef PG8_STAGE
#undef PG8_LDA
#undef PG8_LDB
#undef PG8_MMA
#undef PG8_WAIT_V
#undef PG8_WAIT_L
#undef PG8_BAR
#undef PG8_SCHED
}

typedef f32x4 Acc[2][2][4][2];

struct SchedU {
    static constexpr bool SK = false;
    int G, c, nM, nN, nt; const char* A; const char* B; size_t tA, tB;
    __device__ __forceinline__ void init(int G_, int c_, const void* A_, int lda, const void* B_, int ldb, int nM_, int nN_, int K) {
        G = G_; c = c_; nM = nM_; nN = nN_; nt = K / BK; A = (const char*)A_; B = (const char*)B_; tA = (size_t)256 * lda * 2; tB = (size_t)256 * ldb * 2; }
    __device__ __forceinline__ bool next(int i, Unit& u) const { u.mode = 0; u.slot = 0;
        const int nwg = nM * nN; const long L = (long)i * G + c; if (L >= nwg) return false;
        const int w = xcd_remap((int)L, nwg); int pm, pn; grouped(w, nM, nN, pm, pn);
        u.A = A + (size_t)pm * tA; u.B = B + (size_t)pn * tB; u.nt = nt; u.pm = pm; u.pn = pn; u.z = 0; return true; }
};
struct SchedK {
    static constexpr bool SK = true;
    int nM, nN, n; const char* A; const char* B; size_t tA, tB; int s0, s1, cpos;
    __device__ __forceinline__ void init(int G, int bid, const void* A_, int lda, const void* B_, int ldb, int nM_, int nN_, int K) {
        nM = nM_; nN = nN_; n = K / (2 * BK); A = (const char*)A_; B = (const char*)B_; tA = (size_t)256 * lda * 2; tB = (size_t)256 * ldb * 2;
        cpos = (G % 8 == 0) ? (bid % 8) * (G / 8) + bid / 8 : bid;
        const long TT = (long)nM * nN * n; s0 = (int)((long)cpos * TT / G); s1 = (int)((long)(cpos + 1) * TT / G); }
    __device__ __forceinline__ void piece(Unit& u, int ui, int t0, int nt_, int mode, int slot) const {
        int pm, pn; grouped(ui, nM, nN, pm, pn);
        u.A = A + (size_t)pm * tA + (size_t)t0 * (4 * BK); u.B = B + (size_t)pn * tB + (size_t)t0 * (4 * BK); u.nt = 2 * nt_; u.pm = pm; u.pn = pn; u.z = 0; u.mode = mode; u.slot = slot; }
    __device__ __forceinline__ bool next(int i, Unit& u) const {
        const int u0 = s0 / n, o0 = s0 % n, u1 = s1 / n, e = s1 % n, fstart = (o0 > 0) ? u0 + 1 : u0, nfull = u1 - fstart;
        int k = i;
        if (e > 0) { if (k == 0) { piece(u, u1, 0, e, 1, cpos); return true; } --k; }
        if (k < nfull) { piece(u, fstart + k, 0, n, 0, 0); return true; }
        k -= nfull;
        if (o0 > 0 && k == 0) { piece(u, u0, o0, n - o0, 2, cpos - 1); return true; }
        return false; }
};
struct SchedP1 {
    static constexpr bool SK = false;
    int G, c; const char* h1; const char* WinT;
    __device__ __forceinline__ bool next(int i, Unit& u) const { u.mode = 0; u.slot = 0;
        const int nwg = 1496; const long L = (long)i * G + c; if (L >= nwg) return false;
        int w = xcd_remap((int)L, nwg); int pm, pn; const size_t ts = (size_t)256 * 2048 * 2;
        u.nt = 32; u.z = 0;
        { const int x = w / 187, o = w % 187;
          if (o < 48) w = 48 * x + o; else if (o < 144) w = 384 + 96 * x + (o - 48); else if (o < 176) w = 1240 + 32 * x + (o - 144); else w = 1152 + 11 * x + (o - 176); }
        if (w < 384) { grouped(w, 32, 12, pm, pn); }
        else if (w < 1152) { grouped(w - 384, 32, 24, pm, pn); pn += 20; }
        else if (w < 1240) { grouped(w - 1152, 2, 44, pm, pn); pm += 32; }
        else { grouped(w - 1240, 8, 32, pm, pn); u.z = 1; u.A = WinT + (size_t)(12 + pm) * ts; u.B = h1 + (size_t)pn * ts; u.pm = pm; u.pn = pn; return true; }
        u.A = h1 + (size_t)pm * ts; u.B = WinT + (size_t)pn * ts; u.pm = pm; u.pn = pn; return true; }
};
struct SchedQK {
    static constexpr bool SK = false;
    int G, c; const char* q; const char* k;
    __device__ __forceinline__ bool next(int i, Unit& u) const { u.mode = 0; u.slot = 0;
        const long L = (long)i * G + c; if (L >= 576) return false;
        const int bh = (int)L / 36, tri = (int)L % 36; int pm = 0, rem = tri;
        while (rem > pm) { rem -= pm + 1; ++pm; }
        const int pn = rem, b = bh >> 2, h = bh & 3;
        u.A = q + ((size_t)(b * 2048 + pm * 256) * 1024 + h * 256) * 2; u.B = k + ((size_t)(b * 2048 + pn * 256) * 1024 + h * 256) * 2;
        u.nt = 4; u.pm = pm; u.pn = pn; u.z = bh; return true; }
};
struct SchedSV {
    static constexpr bool SK = false;
    int G, c; const char* S; const char* vT; const char* kwT;
    __device__ __forceinline__ bool next(int i, Unit& u) const { u.mode = 0; u.slot = 0;
        if ((long)i * G >= 288) return false;
        const int o = (i & 1) ? (i * G + (G - 1 - c)) : (i * G + c); if (o >= 288) return false;
        if (o < 32) { const int bh = o >> 1, pn = o & 1, b = bh >> 2, h = bh & 3;
            u.A = kwT + ((size_t)(h * 256) * TP + b * 2048) * 2; u.B = vT + ((size_t)(h * 512 + pn * 256) * TP + b * 2048) * 2; u.nt = 32; u.pm = 0; u.pn = pn; u.z = 16 + bh; return true; }
        const int o2 = o - 32, pm = 7 - (o2 >> 5), rem = o2 & 31, bh = rem >> 1, pn = rem & 1, b = bh >> 2, h = bh & 3;
        u.A = S + ((size_t)(b * 2048 + pm * 256) * 8192 + h * 2048) * 2; u.B = vT + ((size_t)(h * 512 + pn * 256) * TP + b * 2048) * 2; u.nt = 4 * (pm + 1); u.pm = pm; u.pn = pn; u.z = bh; return true; }
};
struct SchedPool {
    static constexpr bool SK = false;
    int G, c; const char* zb; const char* Wg;
    __device__ __forceinline__ bool next(int i, Unit& u) const { u.mode = 0; u.slot = 0;
        const long L = (long)i * G + c; if (L >= 136) return false;
        const int g = (int)L / 34, pm = (int)L % 34;
        u.A = zb + ((size_t)pm * 256 * 1024 + g * 256) * 2; u.B = Wg + (size_t)g * 65536 * 2; u.nt = 4; u.pm = pm; u.pn = 0; u.z = g; return true; }
};

struct SchedPe {
    static constexpr bool SK = false;
    int G, c; const char* p; const char* W;
    __device__ __forceinline__ bool next(int i, Unit& u) const { u.mode = 0; u.slot = 0;
        const int skip = (272 - G > 0 && 272 - G < G) ? 272 - G : 0; if (c < skip) return false;
        const long L = (long)i * (G - skip) + (c - skip); if (L >= 272) return false;
        const int pm = (int)L % 34, pn = (int)L / 34;
        u.A = p + (size_t)pm * 256 * PLE * 2; u.B = W + (size_t)pn * 256 * PLE * 2; u.nt = 4; u.pm = pm; u.pn = pn; u.z = 0; return true; }
};

#define EPI_LAUNDER int lr_ = 64 * wr + fr, lc_ = 32 * wc + 8 * fq; asm volatile("" : "+v"(lr_), "+v"(lc_));
#define EPI_ROWS_BEGIN _Pragma("unroll") for (int ai = 0; ai < 2; ++ai) _Pragma("unroll") for (int m = 0; m < 4; ++m) { const int rl = 128 * ai + 16 * m + lr_;
#define EPI_ROWS_END }

struct EpiP1 {
    bf16_t *u, *q, *k, *v, *so, *ga, *gb, *vT;
    __device__ __forceinline__ void operator()(const Acc& acc, const Unit& un, int wr, int wc, int fr, int fq) const { EPI_LAUNDER
        bf16_t* dst; int ldc; float scale = 1.f; bool sg = false; long row0 = (long)un.pm * 256;
        if (un.z == 1) { dst = vT + un.pn * 256; ldc = TP; }
        else { const int tn = un.pn;
            if (tn < 4) { dst = u + tn * 256; ldc = 1024; }
            else if (tn < 8) { dst = q + (tn - 4) * 256; ldc = 1024; }
            else if (tn < 12) { dst = k + (tn - 8) * 256; ldc = 1024; scale = 0.0625f; }
            else if (tn < 20) { dst = v + (tn - 12) * 256; ldc = 2048; row0 -= TP; }
            else if (tn < 28) { dst = so + (tn - 20) * 256; ldc = 2048; }
            else if (tn < 36) { dst = ga + (tn - 28) * 256; ldc = 2048; sg = true; }
            else { dst = gb + (tn - 36) * 256; ldc = 2048; sg = true; } }
        const int cl0 = lc_;
        EPI_ROWS_BEGIN
            bf16_t* rp = dst + (size_t)(row0 + rl) * ldc + cl0;
#pragma unroll
            for (int bj = 0; bj < 2; ++bj) { f32x4 v0 = acc[ai][bj][m][0], v1 = acc[ai][bj][m][1];
                if (sg) { v0 = sig4(v0); v1 = sig4(v1); } else { v0 = v0 * scale; v1 = v1 * scale; }
                *(u32x4*)(rp + bj * HALF) = pack8(v0, v1); }
        EPI_ROWS_END
    }
};
struct EpiBf {
    bf16_t* dst; int ldc;
    __device__ __forceinline__ void operator()(const Acc& acc, const Unit& un, int wr, int wc, int fr, int fq) const { EPI_LAUNDER
        bf16_t* d0 = dst + (size_t)un.pm * 256 * ldc + un.pn * 256 + lc_;
        EPI_ROWS_BEGIN
            bf16_t* rp = d0 + (size_t)rl * ldc;
#pragma unroll
            for (int bj = 0; bj < 2; ++bj) *(u32x4*)(rp + bj * HALF) = pack8(acc[ai][bj][m][0], acc[ai][bj][m][1]);
        EPI_ROWS_END
    }
};
struct EpiS {
    bf16_t* S; const float* su; const float* sw; float* denp;
    __device__ __forceinline__ void operator()(const Acc& acc, const Unit& un, int wr, int wc, int fr, int fq) const { EPI_LAUNDER
        const int bh = un.z, b = bh >> 2, h = bh & 3; const bool diag = (un.pm == un.pn);
        const int cl0 = lc_;
        f32x4 ww[2][2];
#pragma unroll
        for (int bj = 0; bj < 2; ++bj)
#pragma unroll
            for (int n = 0; n < 2; ++n) ww[bj][n] = *(const f32x4*)(sw + bh * 2048 + un.pn * 256 + bj * HALF + cl0 + 4 * n);
        float uu8[2][4];
#pragma unroll
        for (int ai = 0; ai < 2; ++ai)
#pragma unroll
            for (int m = 0; m < 4; ++m) uu8[ai][m] = su[bh * 2048 + un.pm * 256 + 128 * ai + 16 * m + lr_];
        EPI_ROWS_BEGIN
            const int srow = un.pm * 256 + rl; const float uu = uu8[ai][m]; float rs = 0.f; const int lim = diag ? rl : 0x7fffffff;
            bf16_t* rp = S + (size_t)(b * 2048 + srow) * 8192 + h * 2048 + un.pn * 256 + cl0;
#pragma unroll
            for (int bj = 0; bj < 2; ++bj) { f32x4 o[2];
#pragma unroll
                for (int n = 0; n < 2; ++n)
#pragma unroll
                    for (int e = 0; e < 4; ++e) { float val = acc[ai][bj][m][n][e] * __builtin_amdgcn_exp2f(uu + ww[bj][n][e]);
                        if (bj * HALF + cl0 + 4 * n + e > lim) val = 0.f;
                        o[n][e] = val; rs += val; }
                *(u32x4*)(rp + bj * HALF) = pack8(o[0], o[1]); }
            rs += __shfl_xor(rs, 16); rs += __shfl_xor(rs, 32);
            if (fq == 0) denp[(size_t)(bh * 2048 + srow) * 32 + un.pn * 4 + wc] = rs;
        EPI_ROWS_END
    }
};
struct EpiSV {
    bf16_t* num; float* Cp;
    __device__ __forceinline__ void operator()(const Acc& acc, const Unit& un, int wr, int wc, int fr, int fq) const { EPI_LAUNDER
        const int cl0 = lc_;
        if (un.z < 16) { const int bh = un.z, b = bh >> 2, h = bh & 3;
            bf16_t* d0 = num + (size_t)(b * 2048 + un.pm * 256) * 2048 + h * 512 + un.pn * 256 + cl0;
            EPI_ROWS_BEGIN
                bf16_t* rp = d0 + (size_t)rl * 2048;
#pragma unroll
                for (int bj = 0; bj < 2; ++bj) *(u32x4*)(rp + bj * HALF) = pack8(acc[ai][bj][m][0], acc[ai][bj][m][1]);
            EPI_ROWS_END
        } else { const int bh = un.z - 16;
            float* d0 = Cp + (size_t)bh * 256 * 512 + un.pn * 256 + cl0;
            EPI_ROWS_BEGIN
                float* rp = d0 + (size_t)rl * 512;
#pragma unroll
                for (int bj = 0; bj < 2; ++bj) { *(f32x4*)(rp + bj * HALF) = acc[ai][bj][m][0]; *(f32x4*)(rp + bj * HALF + 4) = acc[ai][bj][m][1]; }
            EPI_ROWS_END
        }
    }
};
struct EpiPool {
    bf16_t* a; const float* sp;
    __device__ __forceinline__ void operator()(const Acc& acc, const Unit& un, int wr, int wc, int fr, int fq) const { EPI_LAUNDER
        const int c0 = un.z * 256 + lc_;
        f32x4 s[2][2];
#pragma unroll
        for (int bj = 0; bj < 2; ++bj)
#pragma unroll
            for (int n = 0; n < 2; ++n) s[bj][n] = *(const f32x4*)(sp + c0 + bj * HALF + 4 * n);
        EPI_ROWS_BEGIN
            bf16_t* rp = a + (size_t)(un.pm * 256 + rl) * 1024 + c0;
#pragma unroll
            for (int bj = 0; bj < 2; ++bj) *(u32x4*)(rp + bj * HALF) = pack8(acc[ai][bj][m][0] * s[bj][0], acc[ai][bj][m][1] * s[bj][1]);
        EPI_ROWS_END
    }
};
struct EpiPA {
    bf16_t* T1; const bf16_t* ga;
    __device__ __forceinline__ void operator()(const Acc& acc, const Unit& un, int wr, int wc, int fr, int fq) const { EPI_LAUNDER
        const size_t o0 = (size_t)un.pm * 256 * 2048 + un.pn * 256 + lc_;
        u32x4 gg[2][4][2];
#pragma unroll
        for (int ai = 0; ai < 2; ++ai)
#pragma unroll
            for (int m = 0; m < 4; ++m)
#pragma unroll
                for (int bj = 0; bj < 2; ++bj) gg[ai][m][bj] = *(const u32x4*)(ga + o0 + (size_t)(128 * ai + 16 * m + lr_) * 2048 + bj * HALF);
        EPI_ROWS_BEGIN
            const size_t ro = o0 + (size_t)rl * 2048;
#pragma unroll
            for (int bj = 0; bj < 2; ++bj) { const u32x4 g = gg[ai][m][bj];
                *(u32x4*)(T1 + ro + bj * HALF) = pack8(acc[ai][bj][m][0] * unlo(g), acc[ai][bj][m][1] * unhi(g)); }
        EPI_ROWS_END
    }
};
struct EpiPB {
    bf16_t* mg; const bf16_t* T1; const bf16_t* gb;
    __device__ __forceinline__ void operator()(const Acc& acc, const Unit& un, int wr, int wc, int fr, int fq) const { EPI_LAUNDER
        const size_t o0 = (size_t)un.pm * 256 * 2048 + un.pn * 256 + lc_;
#pragma unroll
        for (int ai = 0; ai < 2; ++ai) {
            u32x4 g4[4][2], t4[4][2];
#pragma unroll
            for (int m = 0; m < 4; ++m)
#pragma unroll
                for (int bj = 0; bj < 2; ++bj) { const size_t ro = o0 + (size_t)(128 * ai + 16 * m + lr_) * 2048 + bj * HALF; g4[m][bj] = *(const u32x4*)(gb + ro); t4[m][bj] = *(const u32x4*)(T1 + ro); }
            __builtin_amdgcn_sched_barrier(0);
#pragma unroll
            for (int m = 0; m < 4; ++m) { const size_t ro = o0 + (size_t)(128 * ai + 16 * m + lr_) * 2048;
#pragma unroll
                for (int bj = 0; bj < 2; ++bj) *(u32x4*)(mg + ro + bj * HALF) = pack8(unlo(t4[m][bj]) + acc[ai][bj][m][0] * unlo(g4[m][bj]), unhi(t4[m][bj]) + acc[ai][bj][m][1] * unhi(g4[m][bj]));
                __builtin_amdgcn_sched_barrier(0); }
        }
    }
};
struct EpiSq {
    bf16_t* dst; float* ssq;
    __device__ __forceinline__ void operator()(const Acc& acc, const Unit& un, int wr, int wc, int fr, int fq) const { EPI_LAUNDER
        const size_t o0 = (size_t)un.pm * 256 * 2048 + un.pn * 256 + lc_;
        EPI_ROWS_BEGIN
            const size_t ro = o0 + (size_t)rl * 2048; float rs = 0.f;
#pragma unroll
            for (int bj = 0; bj < 2; ++bj) { const f32x4 v0 = acc[ai][bj][m][0], v1 = acc[ai][bj][m][1];
                rs += v0[0] * v0[0] + v0[1] * v0[1] + v0[2] * v0[2] + v0[3] * v0[3] + v1[0] * v1[0] + v1[1] * v1[1] + v1[2] * v1[2] + v1[3] * v1[3];
                *(u32x4*)(dst + ro + bj * HALF) = pack8(v0, v1); }
            rs += __shfl_xor(rs, 16); rs += __shfl_xor(rs, 32);
            if (fq == 0) ssq[(size_t)(un.pm * 256 + rl) * 32 + un.pn * 4 + wc] = rs;
        EPI_ROWS_END
    }
};
struct EpiSwi {
    bf16_t* act; const float* rs;
    __device__ __forceinline__ void operator()(const Acc& acc, const Unit& un, int wr, int wc, int fr, int fq) const { EPI_LAUNDER
        bf16_t* d0 = act + (size_t)un.pm * 256 * DFF + un.pn * 128 + lc_;
        float r8[2][4];
#pragma unroll
        for (int ai = 0; ai < 2; ++ai)
#pragma unroll
            for (int m = 0; m < 4; ++m) r8[ai][m] = rs[un.pm * 256 + 128 * ai + 16 * m + lr_];
        EPI_ROWS_BEGIN
            const float r = r8[ai][m];
            const f32x4 g0 = acc[ai][0][m][0] * r, g1 = acc[ai][0][m][1] * r, u0 = acc[ai][1][m][0] * r, u1 = acc[ai][1][m][1] * r;
            *(u32x4*)(d0 + (size_t)rl * DFF) = pack8(g0 * sig4(g0) * u0, g1 * sig4(g1) * u1);
        EPI_ROWS_END
    }
};
struct EpiPle {
    float* y; const bf16_t* x2; const bf16_t* pe;
    __device__ __forceinline__ void operator()(const Acc& acc, const Unit& un, int wr, int wc, int fr, int fq) const { EPI_LAUNDER
        const size_t o0 = (size_t)un.pm * 256 * 2048 + un.pn * 256 + lc_;
#pragma unroll
        for (int ai = 0; ai < 2; ++ai) {
            u32x4 p4[4][2], x4[4][2];
#pragma unroll
            for (int m = 0; m < 4; ++m)
#pragma unroll
                for (int bj = 0; bj < 2; ++bj) { const size_t ro = o0 + (size_t)(128 * ai + 16 * m + lr_) * 2048 + bj * HALF; p4[m][bj] = *(const u32x4*)(pe + ro); x4[m][bj] = *(const u32x4*)(x2 + ro); }
            __builtin_amdgcn_sched_barrier(0);
#pragma unroll
            for (int m = 0; m < 4; ++m) { const size_t ro = o0 + (size_t)(128 * ai + 16 * m + lr_) * 2048;
#pragma unroll
                for (int bj = 0; bj < 2; ++bj) {
                    *(f32x4*)(y + ro + bj * HALF) = unlo(x4[m][bj]) + sig4(acc[ai][bj][m][0]) * unlo(p4[m][bj]);
                    *(f32x4*)(y + ro + bj * HALF + 4) = unhi(x4[m][bj]) + sig4(acc[ai][bj][m][1]) * unhi(p4[m][bj]); }
                __builtin_amdgcn_sched_barrier(0); }
        }
    }
};

__device__ __forceinline__ void transpose_item(const float* src, int ldw, bf16_t* dst, int ldd, LAS float* scr, int lane, const float* ks = nullptr) {
    f32x4 v[8];
#pragma unroll
    for (int i = 0; i < 8; ++i) v[i] = *(const f32x4*)(src + (size_t)(i * 8 + (lane >> 3)) * ldw + (lane & 7) * 4);
    if (ks) {
        float kv[8];
#pragma unroll
        for (int i = 0; i < 8; ++i) kv[i] = ks[i * 8 + (lane >> 3)];
#pragma unroll
        for (int i = 0; i < 8; ++i) v[i] = v[i] * kv[i]; }
#pragma unroll
    for (int i = 0; i < 8; ++i) { LAS float* s = scr + (i * 8 + (lane >> 3)) * 33 + (lane & 7) * 4; s[0] = v[i][0]; s[1] = v[i][1]; s[2] = v[i][2]; s[3] = v[i][3]; }
    LDS_WAIT();
    const int c = lane & 7;
#pragma unroll
    for (int j = 0; j < 4; ++j) { const int n = (lane >> 3) + 8 * j; const LAS float* s = scr + (8 * c) * 33 + n;
        u32x4 o; o.x = pk2(s[0 * 33], s[1 * 33]); o.y = pk2(s[2 * 33], s[3 * 33]); o.z = pk2(s[4 * 33], s[5 * 33]); o.w = pk2(s[6 * 33], s[7 * 33]);
        *(u32x4*)(dst + (size_t)n * ldd + 8 * c) = o; }
    LDS_WAIT();
}

__device__ __forceinline__ void weight_item(const Params& P, int it, LAS float* scr, int lane) {
    unsigned char* ws = P.ws;
    int r = it;
    if (r < 7168) { const int kb = r / 224, nb = r % 224; transpose_item(P.w_in + (size_t)kb * 64 * NIN + nb * 32, NIN, (bf16_t*)(ws + O_WIN) + (size_t)(nb * 32) * DM + kb * 64, DM, scr, lane); return; } r -= 7168;
    if (r < 4096) { const int kb = r / 128, nb = r % 128; transpose_item(P.w_in + (size_t)kb * 64 * NIN + 7176 + nb * 32, NIN, (bf16_t*)(ws + O_WIN) + (size_t)(7168 + nb * 32) * DM + kb * 64, DM, scr, lane); return; } r -= 4096;
    if (r < 5632) { const int kb = r / 176, nb = r % 176, n0 = nb * 32; transpose_item(P.w_gate + (size_t)kb * 64 * DFF + n0, DFF, (bf16_t*)(ws + O_WGU) + (size_t)((n0 >> 7) * 256 + (n0 & 127)) * DM + kb * 64, DM, scr, lane, P.g_pre_ffn + kb * 64); return; } r -= 5632;
    if (r < 5632) { const int kb = r / 176, nb = r % 176, n0 = nb * 32; transpose_item(P.w_up + (size_t)kb * 64 * DFF + n0, DFF, (bf16_t*)(ws + O_WGU) + (size_t)((n0 >> 7) * 256 + 128 + (n0 & 127)) * DM + kb * 64, DM, scr, lane, P.g_pre_ffn + kb * 64); return; } r -= 5632;
    if (r < 5632) { const int kb = r / 64, nb = r % 64; transpose_item(P.w_down + (size_t)kb * 64 * DM + nb * 32, DM, (bf16_t*)(ws + O_WDN) + (size_t)(nb * 32) * DFF + kb * 64, DFF, scr, lane); return; } r -= 5632;
    if (r < 1024) { const int kb = r / 64, nb = r % 64; transpose_item(P.w_pa + (size_t)kb * 64 * DM + nb * 32, DM, (bf16_t*)(ws + O_WPA) + (size_t)(nb * 32) * DP + kb * 64, DP, scr, lane); return; } r -= 1024;
    if (r < 2048) { const int kb = r / 64, nb = r % 64; transpose_item(P.w_pb + (size_t)kb * 64 * DM + nb * 32, DM, (bf16_t*)(ws + O_WPB) + (size_t)(nb * 32) * DM + kb * 64, DM, scr, lane); return; } r -= 2048;
    if (r < 2048) { const int kb = r / 64, nb = r % 64; transpose_item(P.w_out + (size_t)kb * 64 * DM + nb * 32, DM, (bf16_t*)(ws + O_WOUT) + (size_t)(nb * 32) * DM + kb * 64, DM, scr, lane); return; } r -= 2048;
    if (r < 2048) { const int kb = r / 64, nb = r % 64; transpose_item(P.w_ple_gate + (size_t)kb * 64 * DM + nb * 32, DM, (bf16_t*)(ws + O_WPG) + (size_t)(nb * 32) * DM + kb * 64, DM, scr, lane); return; } r -= 2048;
    if (r < 256) { const int kb = r / 64, nb = r % 64; transpose_item(P.w_ple + (size_t)kb * 64 * DM + nb * 32, DM, (bf16_t*)(ws + O_WPLE) + (size_t)(nb * 32) * PLE + kb * 64, PLE, scr, lane); return; } r -= 256;
    { const int g = r / 32, rr = r % 32, kb = rr / 8, nb = rr % 8;
      transpose_item(P.w_pool_grp + (size_t)g * 65536 + (size_t)kb * 64 * 256 + nb * 32, 256, (bf16_t*)(ws + O_WGRP) + (size_t)g * 65536 + (size_t)(nb * 32) * 256 + kb * 64, 256, scr, lane); }
}
constexpr int N_WITEMS = 7168 + 4096 + 5632 * 3 + 1024 + 2048 * 3 + 256 + 128;
constexpr int W_DN0 = 7168 + 4096 + 5632 * 2, W_PB0 = 7168 + 4096 + 5632 * 3 + 1024, W_LATE0 = W_PB0 + 2048, W_LATE1 = W_LATE0 + 2048 * 2;

template <int W>
__device__ __forceinline__ void pool_z_item(const Params& P, const bf16_t* ub, bf16_t* zb, int t, int ch0) {
    f32x4 sa = {0.f, 0.f, 0.f, 0.f}, sb = {0.f, 0.f, 0.f, 0.f}; float cnt; u32x4 cur;
    if (t < TP) { const int s = t & 2047, n = (s + 1 < W) ? s + 1 : W; cnt = (float)n;
        u32x4 r[W];
#pragma unroll
        for (int i = 0; i < W; ++i) r[i] = (i < n) ? *(const u32x4*)(ub + (size_t)(t - i) * 1024 + ch0) : (u32x4){0u, 0u, 0u, 0u};
        cur = r[0];
#pragma unroll
        for (int i = 0; i < W; ++i) { sa += unlo(r[i]); sb += unhi(r[i]); } }
    else { const int bs = (t - TP) >> 2, s = (t - TP) & 3; cnt = (float)W;
        cur = *(const u32x4*)(ub + (size_t)t * 1024 + ch0);
#pragma unroll
        for (int i = 0; i < W; ++i) { const int e = 15 + s - i;
            if (e >= 15) { const u32x4 r = *(const u32x4*)(ub + (size_t)(TP + bs * 4 + (e - 15)) * 1024 + ch0); sa += unlo(r); sb += unhi(r); }
            else { const float* sp = P.state_pool + ((size_t)bs * 15 + e) * 1024 + ch0; sa += *(const f32x4*)sp; sb += *(const f32x4*)(sp + 4); } } }
    const float ic = 1.f / cnt;
    *(u32x4*)(zb + (size_t)t * 1024 + ch0) = pack8(sa * ic - unlo(cur), sb * ic - unhi(cur));
}

__device__ __forceinline__ void sample_item(const Params& P, int item, LAS float* L) {
    const int tid = threadIdx.x, lane = tid & 63, wid = tid >> 6;
    const int b = item >> 2, h = item & 3, t0 = TP + b * 4;
    unsigned char* ws = P.ws;
    const bf16_t* qb = (const bf16_t*)(ws + O_Q); const bf16_t* kb = (const bf16_t*)(ws + O_K); const bf16_t* vb = (const bf16_t*)(ws + O_V);
    const float* igp = (const float*)(ws + O_IG); const float* lfp = (const float*)(ws + O_LF);
    LAS float* qs = L;
    LAS float* ks = L + 1024;
    LAS float* vs = L + 2048;
    LAS float* n0s = L + 4096;
    LAS float* red = L + 4352;
    LAS float* nred = L + 4608;
    for (int idx = tid; idx < 1024; idx += 512) { const int t = idx >> 8, d = idx & 255;
        qs[d * 4 + t] = bf1(qb[(size_t)(t0 + t) * 1024 + h * 256 + d]); ks[d * 4 + t] = bf1(kb[(size_t)(t0 + t) * 1024 + h * 256 + d]); }
    for (int idx = tid; idx < 2048; idx += 512) { const int t = idx >> 9, e = idx & 511; vs[idx] = bf1(vb[(size_t)(b * 4 + t) * 2048 + h * 512 + e]); }
    if (tid < 256) n0s[tid] = P.state_n[(size_t)(b * 4 + h) * 256 + tid];
    float bc[4], igv[4], mt[4], inter[4], Dt[4][4];
    const float m0 = P.state_m[b * 4 + h];
    { float cs = 0.f;
#pragma unroll
      for (int t = 0; t < 4; ++t) { cs += lfp[(t0 + t) * 4 + h]; bc[t] = cs; igv[t] = igp[(t0 + t) * 4 + h]; } }
#pragma unroll
    for (int t = 0; t < 4; ++t) { const float a = bc[t] + m0; float mm = a;
#pragma unroll
        for (int j = 0; j < 4; ++j) if (j <= t) mm = fmaxf(mm, bc[t] - bc[j] + igv[j]);
        mt[t] = mm; inter[t] = __expf(a - mm);
#pragma unroll
        for (int j = 0; j < 4; ++j) Dt[t][j] = (j <= t) ? __expf(bc[t] - bc[j] + igv[j] - mm) : 0.f; }
    const float m_new = mt[3], bL = bc[3], decay = __expf(bL + m0 - m_new);
    float wk[4];
#pragma unroll
    for (int j = 0; j < 4; ++j) wk[j] = __expf(bL - bc[j] + igv[j] - m_new);
    __syncthreads();
    for (int dt = wid; dt < 20; dt += 8) { float s = 0.f;
        if (dt < 16) { const int t = dt >> 2, j = dt & 3;
#pragma unroll
            for (int i = 0; i < 4; ++i) { const int d = lane + 64 * i; s += qs[d * 4 + t] * ks[d * 4 + j]; } }
        else { const int t = dt - 16;
#pragma unroll
            for (int i = 0; i < 4; ++i) { const int d = lane + 64 * i; s += qs[d * 4 + t] * n0s[d]; } }
        s = wave_sum(s); if (lane == 0) red[dt] = s; }
    __syncthreads();
    LAS float* sc = L + 4384;
    if (tid == 0) {
#pragma unroll
        for (int t = 0; t < 4; ++t) { float ds = inter[t] * red[16 + t];
#pragma unroll
            for (int j = 0; j < 4; ++j) { const float sv = red[t * 4 + j] * Dt[t][j]; sc[8 + t * 4 + j] = sv; ds += sv; }
            sc[t] = inter[t]; sc[4 + t] = fmaxf(fabsf(ds), __expf(-mt[t])); sc[24 + t] = wk[t]; }
    }
    __syncthreads();
    for (int idx = tid; idx < 1024; idx += 512) ks[idx] *= sc[24 + (idx & 3)];
    __syncthreads();
    const int cgp = tid & 127, dg = tid >> 7;
    f32x4 vv[4], nq[4];
#pragma unroll
    for (int j = 0; j < 4; ++j) { vv[j] = *(const LAS f32x4*)(vs + j * 512 + cgp * 4); nq[j] = (f32x4){0.f, 0.f, 0.f, 0.f}; }
    const f32x4* Cin = (const f32x4*)(P.state_C + (size_t)(b * 4 + h) * 256 * 512) + cgp;
    f32x4* Cout = (f32x4*)(P.out + OUT_CS + (size_t)(b * 4 + h) * 256 * 512) + cgp;
    for (int d0 = dg * 64; d0 < dg * 64 + 64; d0 += 16) {
        f32x4 cc[16];
#pragma unroll
        for (int i = 0; i < 16; ++i) cc[i] = __builtin_nontemporal_load(Cin + (size_t)(d0 + i) * 128);
#pragma unroll
        for (int i = 0; i < 16; ++i) { const f32x4 qd = *(const LAS f32x4*)(qs + (d0 + i) * 4), kd = *(const LAS f32x4*)(ks + (d0 + i) * 4);
            nq[0] += cc[i] * qd[0]; nq[1] += cc[i] * qd[1]; nq[2] += cc[i] * qd[2]; nq[3] += cc[i] * qd[3];
            f32x4 cn = cc[i] * decay + vv[0] * kd[0] + vv[1] * kd[1] + vv[2] * kd[2] + vv[3] * kd[3];
            __builtin_nontemporal_store(cn, Cout + (size_t)(d0 + i) * 128); }
    }
#pragma unroll
    for (int t = 0; t < 4; ++t) *(LAS f32x4*)(nred + (dg * 4 + t) * 512 + cgp * 4) = nq[t];
    __syncthreads();
    bf16_t* numb = (bf16_t*)(ws + O_NUM);
#pragma unroll
    for (int i = 0; i < 4; ++i) { const int idx = tid + 512 * i, t = idx >> 9, e = idx & 511;
        const float nqs = nred[(0 * 4 + t) * 512 + e] + nred[(1 * 4 + t) * 512 + e] + nred[(2 * 4 + t) * 512 + e] + nred[(3 * 4 + t) * 512 + e];
        const float it_ = sc[t], dd = sc[4 + t], s0 = sc[8 + t * 4], s1 = sc[9 + t * 4], s2 = sc[10 + t * 4], s3 = sc[11 + t * 4];
        const float val = it_ * nqs + s0 * vs[e] + s1 * vs[512 + e] + s2 * vs[1024 + e] + s3 * vs[1536 + e];
        const float hv = val / dd;
        numb[(size_t)(t0 + t) * 2048 + h * 512 + e] = (bf16_t)(pk2(hv, 0.f) & 0xffffu); }
    if (tid < 256) { const f32x4 kd = *(const LAS f32x4*)(ks + tid * 4);
        P.out[OUT_NS + (size_t)(b * 4 + h) * 256 + tid] = decay * n0s[tid] + kd[0] + kd[1] + kd[2] + kd[3]; }
    if (tid == 0) P.out[OUT_MS + b * 4 + h] = m_new;
    __syncthreads();
}


#define XB_TMO      128
#define XB_XCNT(j)  (256  + 64 * (j))
#define XB_XSUB(j)  (1280 + 64 * (j))
#define XB_XGEN(j)  (2304 + 64 * (j))
#define XB_TOP      3328
#define XB_TOPGEN   3392
#define XCD_BAR_WORDS 3456
#define XB_SPIN_CAP (1u << 22)
__device__ __forceinline__ unsigned xb_ld(unsigned* p)              { return __hip_atomic_load(p, __ATOMIC_RELAXED, __HIP_MEMORY_SCOPE_AGENT); }
__device__ __forceinline__ unsigned xb_add(unsigned* p, unsigned v) { return __hip_atomic_fetch_add(p, v, __ATOMIC_RELAXED, __HIP_MEMORY_SCOPE_AGENT); }
__device__ __forceinline__ unsigned xb_xcc_id() { return (unsigned)__builtin_amdgcn_s_getreg((3 << 11) | 20) & 0xFu; }
#define XB_SPIN(cond, bar) do { unsigned _sp = 0; while (cond) { __builtin_amdgcn_s_sleep(1); \
    if ((++_sp & 255u) == 0u) { if (xb_ld(&(bar)[XB_TMO])) break; if (_sp > XB_SPIN_CAP) { atomicAdd(&(bar)[XB_TMO], 1u); break; } } } } while (0)
struct XcdBarrier { unsigned* bar; unsigned x; volatile LAS unsigned* st; };
__device__ __forceinline__ XcdBarrier xcd_barrier_post(unsigned* bar, volatile LAS unsigned* st) {
    XcdBarrier b; b.bar = bar; b.x = xb_xcc_id(); b.st = st;
    if (threadIdx.x == 0) (void)xb_add(&bar[XB_XCNT(b.x)], 1u);
    return b;
}
__device__ __forceinline__ void xcd_barrier_complete(unsigned* bar, unsigned x, unsigned& nloc, unsigned& nx) {
    const unsigned G = gridDim.x * gridDim.y * gridDim.z;
    unsigned sum, cnt, mine, sp = 0u;
    for (;;) {
        sum = 0u; cnt = 0u; mine = 0u;
#pragma unroll
        for (unsigned j = 0; j < 16; ++j) { const unsigned c = xb_ld(&bar[XB_XCNT(j)]); sum += c; cnt += (c > 0u) ? 1u : 0u; mine = (j == x) ? c : mine; }
        if (sum == G) break;
        __builtin_amdgcn_s_sleep(1);
        if ((++sp & 255u) == 0u) { if (xb_ld(&bar[XB_TMO])) break; if (sp > XB_SPIN_CAP) { atomicAdd(&bar[XB_TMO], 1u); break; } }
    }
    nloc = mine > 0u ? mine : 1u; nx = cnt > 0u ? cnt : 1u;
}
__device__ __forceinline__ void xcd_barrier(const XcdBarrier& b) {
    asm volatile("s_waitcnt vmcnt(0)" ::: "memory");
    __syncthreads();
    if (threadIdx.x == 0) {
        unsigned* bar = b.bar;
        __builtin_amdgcn_s_waitcnt(0);
        unsigned nloc = b.st[0], nx = b.st[1];
        if (nloc == 0u) { xcd_barrier_complete(bar, b.x, nloc, nx); b.st[0] = nloc; b.st[1] = nx; }
        const unsigned old = xb_add(&bar[XB_XSUB(b.x)], 1u);
        const unsigned gen = old / nloc;
        if (old + 1u == (gen + 1u) * nloc) {
            __builtin_amdgcn_fence(__ATOMIC_RELEASE, "agent");
            asm volatile("s_waitcnt vmcnt(0)" ::: "memory");
            const unsigned og = xb_add(&bar[XB_TOP], 1u);
            const unsigned tg = og / nx;
            if (og + 1u == (tg + 1u) * nx) xb_add(&bar[XB_TOPGEN], 1u);
            else XB_SPIN(xb_ld(&bar[XB_TOPGEN]) == tg, bar);
            __builtin_amdgcn_fence(__ATOMIC_ACQUIRE, "agent");
            xb_add(&bar[XB_XGEN(b.x)], 1u);
            asm volatile("s_waitcnt vmcnt(0)" ::: "memory");
        } else {
            XB_SPIN(xb_ld(&bar[XB_XGEN(b.x)]) == gen, bar);
            __builtin_amdgcn_fence(__ATOMIC_ACQUIRE, "agent");
            asm volatile("s_waitcnt vmcnt(0)" ::: "memory");
        }
    }
    __syncthreads();
}

#define WinT ((bf16_t*)(ws + O_WIN))
#define WguT ((bf16_t*)(ws + O_WGU))
#define WdnT ((bf16_t*)(ws + O_WDN))
#define WpaT ((bf16_t*)(ws + O_WPA))
#define WpbT ((bf16_t*)(ws + O_WPB))
#define WoutT ((bf16_t*)(ws + O_WOUT))
#define WpgT ((bf16_t*)(ws + O_WPG))
#define WpleT ((bf16_t*)(ws + O_WPLE))
#define WgrpT ((bf16_t*)(ws + O_WGRP))
#define h1 ((bf16_t*)(ws + O_H1))
#define merged h1
#define so ((bf16_t*)(ws + O_SO))
#define x2b so
#define ga ((bf16_t*)(ws + O_GA))
#define gb ((bf16_t*)(ws + O_GB))
#define numb ((bf16_t*)(ws + O_NUM))
#define tout numb
#define bm ((bf16_t*)(ws + O_BM))
#define h2 bm
#define T1 ((bf16_t*)(ws + O_T1))
#define fout T1
#define pe ((bf16_t*)(ws + O_PE))
#define vs_ ((bf16_t*)(ws + O_V))
#define ub ((bf16_t*)(ws + O_U))
#define qb ((bf16_t*)(ws + O_Q))
#define kb ((bf16_t*)(ws + O_K))
#define zb ((bf16_t*)(ws + O_Z))
#define ab ((bf16_t*)(ws + O_A))
#define vT ((bf16_t*)(ws + O_VT))
#define kwT ((bf16_t*)(ws + O_KWT))
#define pbf ((bf16_t*)(ws + O_PBF))
#define Sall ((bf16_t*)(ws + O_S))
#define act Sall
#define x1b ((bf16_t*)(ws + O_X1))
#define rs2b ((float*)(ws + O_SU))
#define igp ((float*)(ws + O_IG))
#define lfp ((float*)(ws + O_LF))
#define su ((float*)(ws + O_SU))
#define sw ((float*)(ws + O_SW))
#define sem ((float*)(ws + O_SEM))
#define swkf ((float*)(ws + O_SWKF))
#define denp ((float*)(ws + O_DENP))
#define ssq ((float*)(ws + O_SSQ))
#define part ((float*)(ws + O_PART))
#define flags ((unsigned*)(ws + O_FLAG))
#define barw ((unsigned*)(ws + O_BAR))
__global__ void __launch_bounds__(512, 2) mega(Params P) {
    extern __shared__ __attribute__((aligned(16))) unsigned char lds_raw[];
    LAS unsigned char* lds = (LAS unsigned char*)lds_raw;
    cg::grid_group grid = cg::this_grid();
    const int tid = threadIdx.x, lane = tid & 63, wid = __builtin_amdgcn_readfirstlane(tid >> 6), G = gridDim.x, bid = blockIdx.x;
    const int gw = bid * 8 + wid, NGW = G * 8, RPB = (T + G - 1) / G;
    unsigned char* ws = P.ws;

    if constexpr ((PHM >> 0) & 1)
    {
        LAS float* WgT = (LAS float*)lds;
        if (bid == 0) { for (int i = tid; i < 5 * 256 + 1; i += 512) flags[i * 16] = 0u; for (int i = tid; i < XCD_BAR_WORDS; i += 512) barw[i] = 0u; }
        if (tid < 4) ((volatile LAS unsigned*)(lds + LDS_BYTES - 16))[tid] = 0u;
        for (int k = tid; k < 2048; k += 512) { const f32x4 a = *(const f32x4*)(P.w_in + (size_t)k * NIN + 7168), b2 = *(const f32x4*)(P.w_in + (size_t)k * NIN + 7172);
            WgT[0 * 2048 + k] = a[0]; WgT[1 * 2048 + k] = a[1]; WgT[2 * 2048 + k] = a[2]; WgT[3 * 2048 + k] = a[3];
            WgT[4 * 2048 + k] = b2[0]; WgT[5 * 2048 + k] = b2[1]; WgT[6 * 2048 + k] = b2[2]; WgT[7 * 2048 + k] = b2[3]; }
        __syncthreads();
        for (int rk = wid; rk < RPB; rk += 8) { const int t = bid * RPB + rk; if (t >= T) break;

            const float* xr = (t < TP) ? P.x_prompt + (size_t)t * DM : P.x_sample + (size_t)(t - TP) * DM;
            f32x4 v[8]; float ss = 0.f;
#pragma unroll
            for (int j = 0; j < 8; ++j) { v[j] = ((const f32x4*)xr)[lane + 64 * j]; ss += v[j][0] * v[j][0] + v[j][1] * v[j][1] + v[j][2] * v[j][2] + v[j][3] * v[j][3]; }
            ss = wave_sum(ss); const float rstd = rsqrtf(ss * (1.f / DM) + EPS);
            u32x2* hr = (u32x2*)(h1 + (size_t)t * DM);
#pragma unroll
            for (int j = 0; j < 8; ++j) { const f32x4 g = ((const f32x4*)P.g_pre_mix)[lane + 64 * j]; v[j] = v[j] * rstd * g;
                u32x2 o; o.x = pk2(v[j][0], v[j][1]); o.y = pk2(v[j][2], v[j][3]); hr[lane + 64 * j] = o; }
            float gacc[8];
#pragma unroll
            for (int c = 0; c < 8; ++c) { float s = 0.f;
#pragma unroll
                for (int j = 0; j < 8; ++j) { const f32x4 w = *(const LAS f32x4*)(WgT + c * 2048 + 256 * j + 4 * lane); s += v[j][0] * w[0] + v[j][1] * w[1] + v[j][2] * w[2] + v[j][3] * w[3]; }
                gacc[c] = wave_sum(s); }
            if (lane == 0) {
#pragma unroll
                for (int hh = 0; hh < 4; ++hh) { igp[t * 4 + hh] = gacc[hh] + P.b_i[hh]; const float f = gacc[4 + hh] + P.b_f[hh];
                    lfp[t * 4 + hh] = fminf(f, 0.f) - log1pf(__expf(-fabsf(f))); } }
        }
        __syncthreads();
        LAS float* scr = (LAS float*)(lds + 65536) + wid * (64 * 33);
        for (int it = (7 - wid) * G + bid; it < 11264 + 1024 + (N_WITEMS - W_LATE1); it += NGW) {
            const int r = it < 11264 ? it : (it < 11264 + 1024 ? it - 11264 + (W_PB0 - 1024) : it - (11264 + 1024) + W_LATE1);
            weight_item(P, r, scr, lane); }
        for (int idx = bid * 512 + tid; idx < T * 32; idx += G * 512) { const int t = idx >> 5, c8 = (idx & 31) * 8;
            const float* pr = (t < TP) ? P.p_prompt + (size_t)t * PLE : P.p_sample + (size_t)(t - TP) * PLE;
            const f32x4 a = *(const f32x4*)(pr + c8), b2 = *(const f32x4*)(pr + c8 + 4);
            *(u32x4*)(pbf + (size_t)t * PLE + c8) = pack8(a, b2); }
    }
    grid.sync();
    const XcdBarrier xb = xcd_barrier_post(barw, (volatile LAS unsigned*)(lds + LDS_BYTES - 16));

    if constexpr ((PHM >> 1) & 1)
    {
        SchedP1 S1{G, bid, (const char*)h1, (const char*)WinT};
        EpiP1 E1{ub, qb, kb, vs_, so, ga, gb, vT};
        gemm_phase(lds, 2048, 2048, S1, E1);
        {
            const int rem = 1496 % G, nsl = rem ? G - rem : G, sl = rem ? bid - rem : bid;
            if (sl >= 0) { LAS float* scr = (LAS float*)lds + wid * (64 * 33);
                for (int it = W_LATE0 + sl * 8 + wid; it < W_LATE1; it += nsl * 8) weight_item(P, it, scr, lane); }
        }
        const int bh = bid - (G - 16);
        if (bh >= 0 && bh < 16 && wid == 0) {
            const int b = bh >> 2, h = bh & 3; float Bc = 0.f, Mc = 0.f;
            float lv[32], wv[32];
#pragma unroll
            for (int c = 0; c < 32; ++c) { const int t = b * 2048 + c * 64 + lane; lv[c] = lfp[t * 4 + h]; wv[c] = igp[t * 4 + h]; }
#pragma unroll
            for (int c = 0; c < 32; ++c) { const int s = c * 64 + lane;
                float cs = lv[c];
#pragma unroll
                for (int o = 1; o < 64; o <<= 1) { const float y = __shfl_up(cs, o); if (lane >= o) cs += y; }
                const float Bt = Bc + cs, w = wv[c] - Bt; float mx = w;
#pragma unroll
                for (int o = 1; o < 64; o <<= 1) { const float y = __shfl_up(mx, o); if (lane >= o) mx = fmaxf(mx, y); }
                mx = fmaxf(mx, Mc); wv[c] = w;
                su[bh * 2048 + s] = -mx * LOG2E; sw[bh * 2048 + s] = w * LOG2E; sem[bh * 2048 + s] = __expf(-(Bt + mx));
                Bc = __shfl(Bt, 63); Mc = __shfl(mx, 63); }
#pragma unroll
            for (int c = 0; c < 32; ++c) { const int s = c * 64 + lane; swkf[bh * 2048 + s] = __builtin_amdgcn_exp2f((wv[c] - Mc) * LOG2E); }
            if (lane == 0) P.out[OUT_MP + bh] = Bc + Mc;
        }
    }
    xcd_barrier(xb);

    if constexpr ((PHM >> 2) & 1)
    {
        SchedQK S1{G, bid, (const char*)qb, (const char*)kb};
        EpiS E1{Sall, su, sw, denp};
        if constexpr (P2M & 1) gemm_phase(lds, 1024, 1024, S1, E1);
        if constexpr (P2M & 2)
        for (int idx = bid * 512 + tid; idx < T * 128; idx += G * 512) {
            const int t = idx >> 7, ch0 = (idx & 127) * 8, g = ch0 >> 8;
            if (g == 0) pool_z_item<2>(P, ub, zb, t, ch0); else if (g == 1) pool_z_item<4>(P, ub, zb, t, ch0);
            else if (g == 2) pool_z_item<8>(P, ub, zb, t, ch0); else pool_z_item<16>(P, ub, zb, t, ch0);
        }
        for (int idx = bid * 512 + tid; idx < 4 * 15 * 128; idx += G * 512) { const int c8 = (idx & 127) * 8, r = (idx >> 7) % 15, b = idx / (15 * 128);
            const u32x4 v = *(const u32x4*)(ub + (size_t)(b * 2048 + 2033 + r) * 1024 + c8); float* o = P.out + OUT_POOLP + ((size_t)b * 15 + r) * 1024 + c8;
            *(f32x4*)o = unlo(v); *(f32x4*)(o + 4) = unhi(v); }
        for (int idx = bid * 512 + tid; idx < 128 * 15 * 128; idx += G * 512) { const int c8 = (idx & 127) * 8, r = (idx >> 7) % 15, b = idx / (15 * 128);
            float* o = P.out + OUT_POOLS + ((size_t)b * 15 + r) * 1024 + c8;
            if (r < 11) { const float* sp = P.state_pool + ((size_t)b * 15 + r + 4) * 1024 + c8; *(f32x4*)o = *(const f32x4*)sp; *(f32x4*)(o + 4) = *(const f32x4*)(sp + 4); }
            else { const u32x4 v = *(const u32x4*)(ub + (size_t)(TP + b * 4 + (r - 11)) * 1024 + c8); *(f32x4*)o = unlo(v); *(f32x4*)(o + 4) = unhi(v); } }
        if constexpr (P2M & 4) {
            LAS float* scr = (LAS float*)lds + wid * (64 * 33);
            for (int it = gw; it < 128 * 32; it += NGW) { const int tb = it >> 5, db = it & 31, tok0 = tb * 64, d0 = db * 32, b = tok0 >> 11, h = d0 >> 8, bh = b * 4 + h;
#pragma unroll
                for (int i = 0; i < 4; ++i) { const int r = i * 16 + (lane >> 2); const u32x4 raw = *(const u32x4*)(kb + (size_t)(tok0 + r) * 1024 + d0 + (lane & 3) * 8);
                    const float wv = swkf[bh * 2048 + (tok0 & 2047) + r]; LAS float* s = scr + r * 33 + (lane & 3) * 8; const f32x4 a = unlo(raw) * wv, b2 = unhi(raw) * wv;
                    s[0] = a[0]; s[1] = a[1]; s[2] = a[2]; s[3] = a[3]; s[4] = b2[0]; s[5] = b2[1]; s[6] = b2[2]; s[7] = b2[3]; }
                LDS_WAIT();
                const int c = lane & 7;
#pragma unroll
                for (int j = 0; j < 4; ++j) { const int d = (lane >> 3) + 8 * j; const LAS float* s = scr + (8 * c) * 33 + d;
                    u32x4 o; o.x = pk2(s[0 * 33], s[1 * 33]); o.y = pk2(s[2 * 33], s[3 * 33]); o.z = pk2(s[4 * 33], s[5 * 33]); o.w = pk2(s[6 * 33], s[7 * 33]);
                    *(u32x4*)(kwT + (size_t)(d0 + d) * TP + tok0 + 8 * c) = o; }
                LDS_WAIT();
            }
            {
                const int rem = 576 % G, nsl = rem ? G - rem : G, sl = rem ? bid - rem : bid;
                if (sl >= 0) for (int it = 16896 + sl * 8 + wid; it < 16896 + 5632; it += nsl * 8) weight_item(P, it, scr, lane);
            }
        }
        __syncthreads();
    }
    xcd_barrier(xb);

    if constexpr ((PHM >> 3) & 1)
    {
        SchedSV S1{G, bid, (const char*)Sall, (const char*)vT, (const char*)kwT};
        EpiSV E1{numb, P.out + OUT_CP};
        gemm_phase(lds, 8192, 8192, S1, E1);
        SchedPool S2{G, bid, (const char*)zb, (const char*)WgrpT};
        EpiPool E2{ab, P.s_pool};
        gemm_phase(lds, 1024, 256, S2, E2);
        __syncthreads();
        {
            volatile LAS int* qslot = (volatile LAS int*)(lds + LDS_BYTES - 32);
            for (;;) {
                if (tid == 0) *qslot = (int)__hip_atomic_fetch_add(flags + 5 * 4096, 1u, __ATOMIC_RELAXED, __HIP_MEMORY_SCOPE_AGENT);
                __syncthreads();
                const int item = *qslot;
                __syncthreads();
                if (item >= 512) break;
                sample_item(P, item, (LAS float*)lds);
            }
        }
        for (int r = gw; r < 16 * 256; r += NGW) { const int bh = r >> 8, d = r & 255, b = bh >> 2, h = bh & 3; float s = 0.f;
            const bf16_t* kr = kwT + (size_t)(h * 256 + d) * TP + b * 2048;
#pragma unroll
            for (int j = 0; j < 4; ++j) { const u32x4 w = *(const u32x4*)(kr + (lane + 64 * j) * 8); const f32x4 a = unlo(w), b2 = unhi(w); s += a[0] + a[1] + a[2] + a[3] + b2[0] + b2[1] + b2[2] + b2[3]; }
            s = wave_sum(s); if (lane == 0) P.out[OUT_NP + r] = s; }
    }
    xcd_barrier(xb);

    if constexpr ((PHM >> 4) & 1)
    {
        for (int rk = wid; rk < RPB; rk += 8) { const int t = bid * RPB + rk; if (t >= T) break;
            u32x4 raw[4], sr[4]; float dsum[4], emv[4];
#pragma unroll
            for (int h = 0; h < 4; ++h) { raw[h] = *(const u32x4*)(numb + (size_t)t * 2048 + h * 512 + lane * 8); sr[h] = *(const u32x4*)(so + (size_t)t * 2048 + h * 512 + lane * 8); dsum[h] = 0.f; emv[h] = 1.f; }
            if (t < TP) { const int b = t >> 11, s = t & 2047, cnt = 4 * ((s >> 8) + 1);
#pragma unroll
                for (int h = 0; h < 4; ++h) { const int bh = b * 4 + h; dsum[h] = (lane < cnt) ? denp[(size_t)(bh * 2048 + s) * 32 + lane] : 0.f; emv[h] = sem[bh * 2048 + s]; }
#pragma unroll
                for (int o = 1; o < 64; o <<= 1) {
#pragma unroll
                    for (int h = 0; h < 4; ++h) dsum[h] += __shfl_xor(dsum[h], o); }
            }
            f32x4 a[4], b2[4]; float ss[4];
#pragma unroll
            for (int h = 0; h < 4; ++h) { a[h] = unlo(raw[h]); b2[h] = unhi(raw[h]);
                if (t < TP) { const float dd = 1.f / fmaxf(fabsf(dsum[h]), emv[h]); a[h] = a[h] * dd; b2[h] = b2[h] * dd; }
                ss[h] = a[h][0] * a[h][0] + a[h][1] * a[h][1] + a[h][2] * a[h][2] + a[h][3] * a[h][3] + b2[h][0] * b2[h][0] + b2[h][1] * b2[h][1] + b2[h][2] * b2[h][2] + b2[h][3] * b2[h][3]; }
#pragma unroll
            for (int o = 1; o < 64; o <<= 1) {
#pragma unroll
                for (int h = 0; h < 4; ++h) ss[h] += __shfl_xor(ss[h], o); }
#pragma unroll
            for (int h = 0; h < 4; ++h) { const float rstd = rsqrtf(ss[h] * (1.f / 512.f) + EPS);
                const f32x4 g0 = *(const f32x4*)(P.g_head + h * 512 + lane * 8), g1 = *(const f32x4*)(P.g_head + h * 512 + lane * 8 + 4);
                *(u32x4*)(bm + (size_t)t * 2048 + h * 512 + lane * 8) = pack8(a[h] * rstd * g0 * sig4(unlo(sr[h])), b2[h] * rstd * g1 * sig4(unhi(sr[h]))); }
        }
        __syncthreads();
        SchedU S1; S1.init(G, bid, ab, 1024, WpaT, 1024, 34, 8, 1024);
        EpiPA E1{T1, ga};
        gemm_phase(lds, 1024, 1024, S1, E1);
        SchedPe S2{G, bid, (const char*)pbf, (const char*)WpleT};
        EpiBf E2{pe, 2048};
        gemm_phase(lds, PLE, PLE, S2, E2);
        {
            const int skip = (272 - G > 0 && 272 - G < G) ? 272 - G : 0;
            if (bid >= skip) { LAS float* scr = (LAS float*)lds + wid * (64 * 33);
                for (int it = W_PB0 + (bid - skip) * 8 + wid; it < W_PB0 + 2048; it += (G - skip) * 8) weight_item(P, it, scr, lane);
                for (int it = 11264 + (bid - skip) * 8 + wid; it < 11264 + 5632; it += (G - skip) * 8) weight_item(P, it, scr, lane); }
        }
    }
    xcd_barrier(xb);

    if constexpr ((PHM >> 5) & 1)
    {
        SchedK S1; S1.init(G, bid, bm, 2048, WpbT, 2048, 34, 8, 2048);
        EpiPB E1{merged, T1, gb};
        gemm_phase(lds, 2048, 2048, S1, E1, part, flags + 1 * 4096, 8u * (REPI + 1));
    }
    xcd_barrier(xb);

    if constexpr ((PHM >> 6) & 1)
    {
        SchedK S1; S1.init(G, bid, merged, 2048, WoutT, 2048, 34, 8, 2048);
        EpiSq E1{tout, ssq};
        gemm_phase(lds, 2048, 2048, S1, E1, part, flags + 2 * 4096, 8u * (REPI + 1));
    }
    xcd_barrier(xb);

    if constexpr ((PHM >> 7) & 1)
    {
        for (int rk = wid; rk < RPB; rk += 8) { const int t = bid * RPB + rk; if (t >= T) break;

            const float* xr = (t < TP) ? P.x_prompt + (size_t)t * DM : P.x_sample + (size_t)(t - TP) * DM;
            float q = (lane < 32) ? ssq[(size_t)t * 32 + lane] : 0.f; q = wave_sum(q); const float rs1 = rsqrtf(q * (1.f / DM) + EPS);
            f32x4 xa[4], xb[4]; float ss = 0.f;
#pragma unroll
            for (int j = 0; j < 4; ++j) { const int c = lane * 8 + 512 * j; const u32x4 raw = *(const u32x4*)(tout + (size_t)t * DM + c);
                const f32x4 g0 = *(const f32x4*)(P.g_post_mix + c), g1 = *(const f32x4*)(P.g_post_mix + c + 4);
                xa[j] = *(const f32x4*)(xr + c) + unlo(raw) * rs1 * g0; xb[j] = *(const f32x4*)(xr + c + 4) + unhi(raw) * rs1 * g1;
                *(u32x4*)(x1b + (size_t)t * DM + c) = pack8(xa[j], xb[j]);
                ss += xa[j][0] * xa[j][0] + xa[j][1] * xa[j][1] + xa[j][2] * xa[j][2] + xa[j][3] * xa[j][3] + xb[j][0] * xb[j][0] + xb[j][1] * xb[j][1] + xb[j][2] * xb[j][2] + xb[j][3] * xb[j][3]; }
            ss = wave_sum(ss); if (lane == 0) rs2b[t] = rsqrtf(ss * (1.f / DM) + EPS);
        }
    }
    xcd_barrier(xb);

    if constexpr ((PHM >> 8) & 1)
    {
        SchedU S1; S1.init(G, bid, x1b, 2048, WguT, 2048, 34, 44, 2048);
        EpiSwi E1{act, rs2b};
        gemm_phase(lds, 2048, 2048, S1, E1);
        {
            const int rem = 1496 % G, nsl = rem ? G - rem : G, sl = rem ? bid - rem : bid;
            if (sl >= 0) { LAS float* scr = (LAS float*)lds + wid * (64 * 33);
                for (int it = W_DN0 + sl * 8 + wid; it < W_DN0 + 5632; it += nsl * 8) weight_item(P, it, scr, lane); }
        }
    }
    xcd_barrier(xb);

    if constexpr ((PHM >> 9) & 1)
    {
        SchedK S1; S1.init(G, bid, act, DFF, WdnT, DFF, 34, 8, DFF);
        EpiSq E1{fout, ssq};
        gemm_phase(lds, DFF, DFF, S1, E1, part, flags + 3 * 4096, 8u * (REPI + 1));
    }
    xcd_barrier(xb);

    if constexpr ((PHM >> 10) & 1)
    {
        for (int rk = wid; rk < RPB; rk += 8) { const int t = bid * RPB + rk; if (t >= T) break;

            float q = (lane < 32) ? ssq[(size_t)t * 32 + lane] : 0.f; q = wave_sum(q); const float rs1 = rsqrtf(q * (1.f / DM) + EPS);
#pragma unroll
            for (int j = 0; j < 4; ++j) { const int c = lane * 8 + 512 * j; const u32x4 raw = *(const u32x4*)(fout + (size_t)t * DM + c);
                const f32x4 g0 = *(const f32x4*)(P.g_post_ffn + c), g1 = *(const f32x4*)(P.g_post_ffn + c + 4);
                const u32x4 xr1 = *(const u32x4*)(x1b + (size_t)t * DM + c);
                const f32x4 a = unlo(xr1) + unlo(raw) * rs1 * g0, b2 = unhi(xr1) + unhi(raw) * rs1 * g1;
                *(u32x4*)(x2b + (size_t)t * DM + c) = pack8(a, b2); }
        }
    }
    xcd_barrier(xb);

    if constexpr ((PHM >> 11) & 1)
    {
        SchedK S1; S1.init(G, bid, x2b, 2048, WpgT, 2048, 34, 8, 2048);
        EpiPle E1{P.out, x2b, pe};
        gemm_phase(lds, 2048, 2048, S1, E1, part, flags + 4 * 4096, 8u * (REPI + 1));
    }
}

#undef WinT
#undef WguT
#undef WdnT
#undef WpaT
#undef WpbT
#undef WoutT
#undef WpgT
#undef WpleT
#undef WgrpT
#undef h1
#undef merged
#undef so
#undef x2b
#undef ga
#undef gb
#undef numb
#undef tout
#undef bm
#undef h2
#undef T1
#undef fout
#undef pe
#undef vs_
#undef ub
#undef qb
#undef kb
#undef zb
#undef ab
#undef vT
#undef kwT
#undef pbf
#undef Sall
#undef act
#undef x1b
#undef rs2b
#undef igp
#undef lfp
#undef su
#undef sw
#undef sem
#undef swkf
#undef denp
#undef ssq
#undef part
#undef flags
#undef barw

extern "C" void kernel_launch(void* const* d_in, const int* in_sizes, int n_in, void* d_out, int out_size, void* d_ws, size_t ws_size, hipStream_t stream) {
    static int grid = 0;
    if (grid == 0) {
        if (n_in != 26 || ws_size < O_END) { fprintf(stderr, "kernel_launch: unexpected n_in %d or workspace %zu < %zu\n", n_in, ws_size, (size_t)O_END); grid = -1; return; }
        int dev = 0, cus = 0, per_cu = 0;
        (void)hipGetDevice(&dev);
        (void)hipDeviceGetAttribute(&cus, hipDeviceAttributeMultiprocessorCount, dev);
        if (hipFuncSetAttribute((const void*)mega, hipFuncAttributeMaxDynamicSharedMemorySize, LDS_BYTES) != hipSuccess) { fprintf(stderr, "kernel_launch: hipFuncSetAttribute failed\n"); grid = -1; return; }
        if (hipOccupancyMaxActiveBlocksPerMultiprocessor(&per_cu, (const void*)mega, 512, LDS_BYTES) != hipSuccess || per_cu < 1) { fprintf(stderr, "kernel_launch: occupancy query gave %d\n", per_cu); per_cu = 1; }
        (void)hipGetLastError();
        grid = cus * 1;
        if (grid > 256) grid = 256;
    }
    if (grid < 0) return;
    Params p{};
    const float** pp = (const float**)&p;
    for (int i = 0; i < 26; ++i) pp[i] = (const float*)d_in[i];
    p.out = (float*)d_out; p.ws = (unsigned char*)d_ws;
    void* args[] = {&p};
    hipError_t e = hipLaunchCooperativeKernel((const void*)mega, dim3(grid), dim3(512), args, LDS_BYTES, stream);
    if (e != hipSuccess) fprintf(stderr, "cooperative launch failed: %s (grid %d)\n", hipGetErrorString(e), grid);
}
```
